# Optimizing an MI355X kernel written in HIP

```python
import jax, jax.numpy as jnp
from jax import lax
import numpy as np

D_MODEL = 1024
BATCH = 8
SEQ = 2048
DEPTH = 2
DEC_BATCH = 128
DEC_SEQ = 8
PAST_LEN = 16384
PAGE_SIZE = 128

N_META = 16
RET_HEADS = 8
RET_DK = D_MODEL // RET_HEADS
RET_DV = D_MODEL // RET_HEADS
RET_QK = RET_HEADS * RET_DK
RET_V = RET_HEADS * RET_DV
RET_CHUNK = 128
ROPE_BASE = 10000.0
D_CONV = D_MODEL
CONV_W = 3
D_FF = ((8 * D_MODEL + 3 * 256 - 1) // (3 * 256)) * 256
EPS = 1e-6
SPLITS = (RET_QK, RET_QK, RET_V, RET_V, D_CONV, D_CONV, D_CONV, D_MODEL, D_MODEL)
N_IN = RET_QK * 2 + RET_V * 2 + D_CONV * 3 + D_MODEL * 2

kernel_name = "retention_shortconv_gated_hybrid_step"


def _rms(x, g):
    x32 = x.astype(jnp.float32)
    y = x32 * lax.rsqrt(jnp.mean(x32 * x32, axis=-1, keepdims=True) + EPS)
    return (y * g.astype(jnp.float32)).astype(x.dtype)


def _split(proj):
    outs, start = [], 0
    for w in SPLITS:
        outs.append(proj[..., start:start + w])
        start += w
    return outs


def _rotary(t, pos):
    half = t.shape[-1] // 2
    inv = jnp.power(ROPE_BASE, -jnp.arange(half, dtype=jnp.float32) / half)
    ang = pos[:, None] * inv[None, :]
    cos, sin = jnp.cos(ang), jnp.sin(ang)
    t1, t2 = t[..., :half], t[..., half:]
    return jnp.concatenate([t1 * cos - t2 * sin, t1 * sin + t2 * cos], axis=-1)


def _log_gamma():
    return jnp.log1p(-jnp.exp2(-5.0 - jnp.arange(RET_HEADS, dtype=jnp.float32)))


def _ret_chunk(q, k, v, s, log_g):
    L = q.shape[2]
    idx = jnp.arange(L, dtype=jnp.float32)
    diff = idx[:, None] - idx[None, :]
    dmask = jnp.where(diff >= 0, jnp.exp(log_g[:, None, None] * jnp.maximum(diff, 0.0)[None]), 0.0)
    scores = jnp.einsum("bhid,bhjd->bhij", q, k) * dmask[None]
    inner = jnp.einsum("bhij,bhje->bhie", scores, v)
    qdec = jnp.exp(log_g[:, None] * (idx + 1.0)[None])[None, :, :, None]
    cross = jnp.einsum("bhid,bhde->bhie", q, s) * qdec
    kdec = jnp.exp(log_g[:, None] * (L - 1.0 - idx)[None])[None, :, :, None]
    s_new = jnp.exp(log_g * L)[None, :, None, None] * s + jnp.einsum("bhjd,bhje->bhde", k * kdec, v)
    return inner + cross, s_new


def _retention(q, k, v, s0, lead):
    log_g = _log_gamma()
    b, h, L, _ = q.shape
    o_lead, s = _ret_chunk(q[:, :, :lead], k[:, :, :lead], v[:, :, :lead], s0, log_g)
    rest = L - lead
    if rest == 0:
        return o_lead, s
    nc = rest // RET_CHUNK

    def blocks(t):
        return jnp.moveaxis(t[:, :, lead:].reshape(b, h, nc, RET_CHUNK, t.shape[-1]), 2, 0)

    def step(st, qkv):
        o, st = _ret_chunk(qkv[0], qkv[1], qkv[2], st, log_g)
        return st, o

    s, o_rest = lax.scan(step, s, (blocks(q), blocks(k), blocks(v)))
    o_rest = jnp.moveaxis(o_rest, 0, 2).reshape(b, h, rest, v.shape[-1])
    return jnp.concatenate([o_lead, o_rest], axis=2), s


def _mixer(hn, pos, s0, cprev, lead, w_in, conv_w, w_ret_o, w_conv_o, w_o):
    b, L, _ = hn.shape
    proj = hn @ w_in
    q, k, v, g, bg, cg, hc, ga, gb = _split(proj)

    def heads(t, d):
        return t.reshape(b, L, RET_HEADS, d).transpose(0, 2, 1, 3).astype(jnp.float32)

    qh = _rotary(heads(q, RET_DK), pos)
    kh = _rotary(heads(k, RET_DK), pos) * (RET_DK ** -0.5)
    vh = heads(v, RET_DV)
    o, s_new = _retention(qh, kh, vh, s0.astype(jnp.float32), lead)
    mu = jnp.mean(o, axis=-1, keepdims=True)
    var = jnp.mean(jnp.square(o - mu), axis=-1, keepdims=True)
    o = ((o - mu) * lax.rsqrt(var + EPS)).transpose(0, 2, 1, 3).reshape(b, L, RET_V).astype(hn.dtype)
    ret_out = (jax.nn.silu(g) * o) @ w_ret_o

    u = cg * hc
    full = jnp.concatenate([cprev.astype(u.dtype), u], axis=1)
    y = conv_w[0] * full[:, 0:L]
    for j in range(1, CONV_W):
        y = y + conv_w[j] * full[:, j:j + L]
    conv_out = (bg * y) @ w_conv_o

    merged = jax.nn.sigmoid(ga) * ret_out + jax.nn.sigmoid(gb) * conv_out
    return merged @ w_o, s_new, full[:, -(CONV_W - 1):]


def _ffn(hn, w_gate_up, w_down):
    gu = hn @ w_gate_up
    return (jax.nn.silu(gu[..., :D_FF]) * gu[..., D_FF:]) @ w_down


def _trunk(h, pos, s_in, c_in, lead, norm_mix_g, w_in, conv_w, w_ret_o, w_conv_o, w_o,
           norm_ffn_g, w_gate_up, w_down, final_norm_g):
    s_out, c_out = [], []
    for l in range(DEPTH):
        m, s, c = _mixer(_rms(h, norm_mix_g[l]), pos, s_in[l], c_in[l], lead,
                         w_in[l], conv_w[l], w_ret_o[l], w_conv_o[l], w_o[l])
        h = h + m
        h = h + _ffn(_rms(h, norm_ffn_g[l]), w_gate_up[l], w_down[l])
        s_out.append(s)
        c_out.append(c)
    return _rms(h, final_norm_g), jnp.stack(s_out), jnp.stack(c_out)


def setup_inputs(seed: int = 0) -> dict:
    key = jax.random.key(seed)
    ks = jax.random.split(key, 16)
    f32 = jnp.float32
    n = lambda k, shape, s: jax.random.normal(k, shape, f32) * s
    return {
        "x_prompt": n(ks[0], (BATCH, SEQ, D_MODEL), 1.0),
        "x_sample": n(ks[1], (DEC_BATCH, DEC_SEQ, D_MODEL), 1.0),
        "state_ret": n(ks[2], (DEPTH, DEC_BATCH, RET_HEADS, RET_DK, RET_DV), 0.5),
        "state_conv": n(ks[3], (DEPTH, DEC_BATCH, CONV_W - 1, D_CONV), 1.0),
        "meta_tokens": n(ks[4], (N_META, D_MODEL), 1.0),
        "norm_mix_g": 1.0 + n(ks[5], (DEPTH, D_MODEL), 0.05),
        "w_in": n(ks[6], (DEPTH, D_MODEL, N_IN), D_MODEL ** -0.5),
        "conv_w": n(ks[7], (DEPTH, CONV_W, D_CONV), CONV_W ** -0.5),
        "w_ret_o": n(ks[8], (DEPTH, RET_V, D_MODEL), RET_V ** -0.5),
        "w_conv_o": n(ks[9], (DEPTH, D_CONV, D_MODEL), D_CONV ** -0.5),
        "w_o": n(ks[10], (DEPTH, D_MODEL, D_MODEL), D_MODEL ** -0.5),
        "norm_ffn_g": 1.0 + n(ks[11], (DEPTH, D_MODEL), 0.05),
        "w_gate_up": n(ks[12], (DEPTH, D_MODEL, 2 * D_FF), D_MODEL ** -0.5),
        "w_down": n(ks[13], (DEPTH, D_FF, D_MODEL), D_FF ** -0.5),
        "final_norm_g": 1.0 + n(ks[14], (D_MODEL,), 0.05),
    }


def reference(x_prompt, x_sample, state_ret, state_conv, meta_tokens, norm_mix_g, w_in, conv_w,
              w_ret_o, w_conv_o, w_o, norm_ffn_g, w_gate_up, w_down, final_norm_g):
    weights = (norm_mix_g, w_in, conv_w, w_ret_o, w_conv_o, w_o, norm_ffn_g, w_gate_up, w_down, final_norm_g)

    meta = jnp.broadcast_to(meta_tokens[None].astype(x_prompt.dtype), (BATCH, N_META, D_MODEL))
    h_p = jnp.concatenate([meta, x_prompt], axis=1)
    pos_p = jnp.arange(N_META + SEQ, dtype=jnp.float32)
    s0_p = jnp.zeros((DEPTH, BATCH, RET_HEADS, RET_DK, RET_DV), state_ret.dtype)
    c0_p = jnp.zeros((DEPTH, BATCH, CONV_W - 1, D_CONV), state_conv.dtype)
    y_p, s_p, c_p = _trunk(h_p, pos_p, s0_p, c0_p, N_META, *weights)
    y_prompt = y_p[:, N_META:]

    pos_s = PAST_LEN + jnp.arange(DEC_SEQ, dtype=jnp.float32)
    y_sample, s_s, c_s = _trunk(x_sample, pos_s, state_ret, state_conv, DEC_SEQ, *weights)

    return (y_prompt, y_sample, s_p.astype(state_ret.dtype), c_p.astype(state_conv.dtype),
            s_s.astype(state_ret.dtype), c_s.astype(state_conv.dtype))
```

```cpp
#include <hip/hip_runtime.h>
#include <hip/hip_cooperative_groups.h>
#include <cstdio>
#include <cstdint>
namespace cg = cooperative_groups;

namespace pg8 {
#define PG8_LAS __attribute__((address_space(3)))
typedef unsigned short bf16_t;
typedef short bf16x8 __attribute__((ext_vector_type(8)));
typedef float f32x4 __attribute__((ext_vector_type(4)));
typedef unsigned u32x4 __attribute__((ext_vector_type(4)));
constexpr int BM = 256, BK = 64, HALF = 128, HTB = HALF * BK * 2  , STAGE_BYTES = 8 * HTB, NXCD = 8, WGM = 8;

__host__ __device__ __forceinline__ int lds_byte(int r, int c) { const int st = (r >> 4) * 2 + (c >> 5), rr = r & 15, cc = c & 31, ob = rr * 64 + cc * 2; return st * 1024 + (ob ^ (((ob >> 9) & 1) << 5)); }
__host__ __device__ __forceinline__ void stage_rc(int b, int& R, int& C) { const int st = b / 1024, sb = b % 1024, swz = sb ^ (((sb >> 9) & 1) << 5); R = (st >> 1) * 16 + swz / 64; C = (st & 1) * 32 + (swz % 64) / 2; }
__host__ __device__ __forceinline__ int perm32(int rho) { const int n = rho >> 4, i = rho & 15; return 8 * (i >> 2) + 4 * n + (i & 3); }

struct Unit { int pm, pn, kt0, nkt; };
struct Gemm { const bf16_t* A; const bf16_t* Bt; int M, N, K; };

struct StaticOrder {
    int nM, nN, nwg, G, c;
    int nktf;
    __host__ __device__ void init(int M, int N, int G_, int c_, int K) { nM = M / BM; nN = N / BM; nwg = nM * nN; G = G_; c = c_; nktf = K / BK; }
    __host__ __device__ bool next(int i, Unit& u) const { return map((long)i * G + c, u); }
    __host__ __device__ bool map(long L, Unit& u) const {
        const bool ok = L < nwg; if (!ok) L = 0;
        u.kt0 = 0; u.nkt = nktf;
        int wgid = (int)L; { const int q = nwg / NXCD, r = nwg % NXCD, xcd = wgid % NXCD, off = wgid / NXCD; wgid = (xcd < r ? xcd * (q + 1) : r * (q + 1) + (xcd - r) * q) + off; }
        const int nig = WGM * nN, gid = wgid / nig, fm = gid * WGM, gsz = (nM - fm) < WGM ? (nM - fm) : WGM;
        u.pm = fm + ((wgid % nig) % gsz); u.pn = (wgid % nig) / gsz; return ok;
    }
    __device__ __forceinline__ void a_ready(const Unit&) const {}
    __device__ __forceinline__ void done(const Unit&) const {}
};

struct OneOf {
    StaticOrder base; long L;
    __host__ __device__ void init(int M, int N, int K, long L_) { base.init(M, N, 1, 0, K); L = L_; }
    __host__ __device__ bool next(int i, Unit& u) const { const bool ok = base.map(L < 0 ? 0 : L, u); return ok && i == 0 && L >= 0; }
    __device__ __forceinline__ void a_ready(const Unit&) const {}
    __device__ __forceinline__ void done(const Unit&) const {}
};

template <int S, int NN> struct SplitOrder {
    StaticOrder base; int nrest, nkp, G, c;
    __host__ __device__ void init(int M0, int Mtot, int N, int K, int G_, int c_) { base.init(M0, N, G_, c_, K); nrest = ((Mtot - M0) / BM) * NN * S; nkp = (K / BK) / S; G = G_; c = c_; }
    __host__ __device__ bool next(int i, Unit& u) const {
        const long L = (long)i * G + c; const bool full = L < base.nwg;
        Unit a; (void)base.map(full ? L : 0, a);
        const unsigned p = full ? 0u : (unsigned)(L - base.nwg);
        const unsigned t = p / (unsigned)S, s = p - t * (unsigned)S;
        u.pm = full ? a.pm : base.nM + (int)(t / (unsigned)NN); u.pn = full ? a.pn : (int)(t % (unsigned)NN);
        u.kt0 = full ? 0 : (int)s * nkp; u.nkt = full ? base.nktf : nkp;
        return full || p < (unsigned)nrest;
    }
    __device__ __forceinline__ void a_ready(const Unit&) const {}
    __device__ __forceinline__ void done(const Unit&) const {}
};

__device__ __forceinline__ unsigned cvt_pk_bf16(float lo, float hi) { unsigned r; asm volatile("v_cvt_pk_bf16_f32 %0, %1, %2" : "=v"(r) : "v"(lo), "v"(hi)); return r; }
typedef float f32x2 __attribute__((ext_vector_type(2)));

typedef unsigned u32x2 __attribute__((ext_vector_type(2)));
__device__ __forceinline__ float bflo(unsigned w) { return __builtin_bit_cast(float, w << 16); }
__device__ __forceinline__ float bfhi(unsigned w) { return __builtin_bit_cast(float, w & 0xffff0000u); }
__device__ __forceinline__ float sigm(float x) { return __builtin_amdgcn_rcpf(1.f + __expf(-x)); }
__device__ __forceinline__ float silu(float x) { return x * __builtin_amdgcn_rcpf(1.f + __expf(-x)); }
__device__ __forceinline__ u32x4 pack8(const f32x4 a, const f32x4 b) { u32x4 w; w.x = cvt_pk_bf16(a[0], a[1]); w.y = cvt_pk_bf16(a[2], a[3]); w.z = cvt_pk_bf16(b[0], b[1]); w.w = cvt_pk_bf16(b[2], b[3]); return w; }

struct EpiProj {
    static constexpr bool PERM = true, AFTER_DRAIN = false;
    bf16_t* P; size_t bstride; const float* tab;
    __device__ __forceinline__ void operator()(const f32x4 (&acc)[2][2][4][2], const Unit& u, int wr, int wc, int fr, int fq) const {
        const int pn = u.pn; const int row0 = u.pm * BM + wr * 64 + fr;
        if (pn < 8) {
            const int X = 2 * (pn & 3) + (wc >> 1), dl = (wc & 1) * 32 + 8 * fq;
            const float ksc = pn >= 4 ? 0.08838834764831845f : 1.f;
            bf16_t* base = P + (size_t)(pn >> 2) * bstride + X * 128 + dl;
#pragma unroll
            for (int ai = 0; ai < 2; ++ai)
#pragma unroll
                for (int m = 0; m < 4; ++m) { const int row = row0 + ai * HALF + m * 16;
                    const int pidx = row < 16384 ? 16 + (row & 2047) : row < 16512 ? ((row - 16384) & 15) : row < 17536 ? 2064 + ((row - 16512) & 7) : 0;
                    const f32x4* tp = (const f32x4*)(tab + ((size_t)pidx * 64 + dl) * 2);
                    const f32x4 t0 = tp[0], t1 = tp[1], t2 = tp[2], t3 = tp[3];
                    const f32x4 c0 = {t0.x, t0.z, t1.x, t1.z}, s0 = {t0.y, t0.w, t1.y, t1.w}, c1 = {t2.x, t2.z, t3.x, t3.z}, s1 = {t2.y, t2.w, t3.y, t3.w};
                    const f32x4 a0 = acc[ai][0][m][0], a1 = acc[ai][0][m][1], b0 = acc[ai][1][m][0], b1 = acc[ai][1][m][1];
                    const f32x4 o10 = (a0 * c0 - b0 * s0) * ksc, o11 = (a1 * c1 - b1 * s1) * ksc, o20 = (a0 * s0 + b0 * c0) * ksc, o21 = (a1 * s1 + b1 * c1) * ksc;
                    bf16_t* rowp = base + (size_t)row * 1024;
                    *(u32x4*)rowp = pack8(o10, o11); *(u32x4*)(rowp + 64) = pack8(o20, o21);
                    asm volatile("" ::: "memory"); }
        } else if (pn >= 20 && pn < 28) {
            bf16_t* base = P + 5 * bstride + (pn - 20) * 128 + wc * 32 + 8 * fq;
#pragma unroll
            for (int ai = 0; ai < 2; ++ai)
#pragma unroll
                for (int m = 0; m < 4; ++m) { bf16_t* rowp = base + (size_t)(row0 + ai * HALF + m * 16) * 1024;
                    const f32x4 v0 = acc[ai][0][m][0] * acc[ai][1][m][0], v1 = acc[ai][0][m][1] * acc[ai][1][m][1];
                    *(u32x4*)rowp = pack8(v0, v1); }
        } else {
            int buf, colt, act;
            if (pn < 20) { buf = pn >> 2; colt = (pn & 3) * 256; act = (buf == 3) ? 1 : 0; }
            else { buf = 6 + ((pn - 28) >> 2); colt = ((pn - 28) & 3) * 256; act = 2; }
            bf16_t* base = P + (size_t)buf * bstride + colt + wc * 32 + 8 * fq;
#pragma unroll
            for (int ai = 0; ai < 2; ++ai)
#pragma unroll
                for (int m = 0; m < 4; ++m) { bf16_t* rowp = base + (size_t)(row0 + ai * HALF + m * 16) * 1024;
#pragma unroll
                    for (int bj = 0; bj < 2; ++bj) { f32x4 v0 = acc[ai][bj][m][0], v1 = acc[ai][bj][m][1];
                        if (act == 1) {
#pragma unroll
                            for (int j = 0; j < 4; ++j) { v0[j] = silu(v0[j]); v1[j] = silu(v1[j]); } }
                        else if (act == 2) {
#pragma unroll
                            for (int j = 0; j < 4; ++j) { v0[j] = sigm(v0[j]); v1[j] = sigm(v1[j]); } }
                        *(u32x4*)(rowp + bj * HALF) = pack8(v0, v1); } }
        }
    }
};

struct EpiGateUp {
    static constexpr bool PERM = true, AFTER_DRAIN = false;
    bf16_t* O; int ldc;
    __device__ __forceinline__ void operator()(const f32x4 (&acc)[2][2][4][2], const Unit& u, int wr, int wc, int fr, int fq) const {
        const int row0 = u.pm * BM + wr * 64 + fr; bf16_t* base = O + u.pn * 128 + wc * 32 + 8 * fq;
#pragma unroll
        for (int ai = 0; ai < 2; ++ai)
#pragma unroll
            for (int m = 0; m < 4; ++m) { bf16_t* rowp = base + (size_t)(row0 + ai * HALF + m * 16) * ldc; f32x4 v0, v1;
#pragma unroll
                for (int j = 0; j < 4; ++j) { v0[j] = silu(acc[ai][0][m][0][j]) * acc[ai][1][m][0][j]; v1[j] = silu(acc[ai][0][m][1][j]) * acc[ai][1][m][1][j]; }
                *(u32x4*)rowp = pack8(v0, v1); }
    }
};

template <bool ADD> struct EpiGate {
    static constexpr bool PERM = true, AFTER_DRAIN = false;
    bf16_t* MG; const bf16_t* Gt;
    __device__ __forceinline__ void operator()(const f32x4 (&acc)[2][2][4][2], const Unit& u, int wr, int wc, int fr, int fq) const {
        const int row0 = u.pm * BM + wr * 64 + fr; const size_t col0 = (size_t)u.pn * BM + wc * 32 + 8 * fq;
#pragma unroll
        for (int ai = 0; ai < 2; ++ai)
#pragma unroll
            for (int m = 0; m < 4; ++m) { const size_t off = (size_t)(row0 + ai * HALF + m * 16) * 1024 + col0;
#pragma unroll
                for (int bj = 0; bj < 2; ++bj) { const u32x4 gw = *(const u32x4*)(Gt + off + bj * HALF);
                    f32x4 v0 = acc[ai][bj][m][0], v1 = acc[ai][bj][m][1];
                    v0[0] *= bflo(gw.x); v0[1] *= bfhi(gw.x); v0[2] *= bflo(gw.y); v0[3] *= bfhi(gw.y);
                    v1[0] *= bflo(gw.z); v1[1] *= bfhi(gw.z); v1[2] *= bflo(gw.w); v1[3] *= bfhi(gw.w);
                    if (ADD) { const u32x4 pw = *(const u32x4*)(MG + off + bj * HALF);
                        v0[0] += bflo(pw.x); v0[1] += bfhi(pw.x); v0[2] += bflo(pw.y); v0[3] += bfhi(pw.y);
                        v1[0] += bflo(pw.z); v1[1] += bfhi(pw.z); v1[2] += bflo(pw.w); v1[3] += bfhi(pw.w); }
                    *(u32x4*)(MG + off + bj * HALF) = pack8(v0, v1); }
                asm volatile("" ::: "memory"); }
    }
};

struct EpiResid {
    static constexpr bool PERM = false, AFTER_DRAIN = false;
    const float* X32; bf16_t* H; bf16_t* PART; int nkt_full, row0p, prows;
    __device__ __forceinline__ void operator()(const f32x4 (&acc)[2][2][4][2], const Unit& u, int wr, int wc, int fr, int fq) const {
        const int row0 = u.pm * BM + wr * 64 + fr; const int col0 = u.pn * BM + wc * 32 + 4 * fq;
        const bool part = u.nkt != nkt_full;
        bf16_t* pbase = PART + ((long)(u.kt0 / u.nkt) * prows - row0p) * 1024;
#pragma unroll
        for (int ai = 0; ai < 2; ++ai)
#pragma unroll
            for (int m = 0; m < 4; ++m) { const size_t ro = (size_t)(row0 + ai * HALF + m * 16) * 1024 + col0;
#pragma unroll
                for (int bj = 0; bj < 2; ++bj)
#pragma unroll
                    for (int n = 0; n < 2; ++n) { const size_t o = ro + bj * HALF + n * 16;
                        if (part) { u32x2 w; w.x = cvt_pk_bf16(acc[ai][bj][m][n][0], acc[ai][bj][m][n][1]); w.y = cvt_pk_bf16(acc[ai][bj][m][n][2], acc[ai][bj][m][n][3]); *(u32x2*)(pbase + o) = w; }
                        else { f32x4 r;
                            if (X32) r = *(const f32x4*)(X32 + o);
                            else { const u32x2 hw = *(const u32x2*)(H + o); r = (f32x4){bflo(hw.x), bfhi(hw.x), bflo(hw.y), bfhi(hw.y)}; }
                            r = r + acc[ai][bj][m][n];
                            u32x2 w; w.x = cvt_pk_bf16(r[0], r[1]); w.y = cvt_pk_bf16(r[2], r[3]); *(u32x2*)(H + o) = w; } }
                asm volatile("" ::: "memory"); }
    }
};

template <class Epi, class Sched, bool ALIGN_EPI = false, bool SP2 = false>
__device__ __forceinline__ void gemm_phase(PG8_LAS unsigned char* lds, const Gemm g, const Sched& S, const Epi& E) {
    int tid_ = threadIdx.x; asm volatile("" : "+v"(tid_));
    const int tid = tid_, wid = __builtin_amdgcn_readfirstlane(tid >> 6), lane = tid & 63, wr = wid >> 2, wc = wid & 3, fr = lane & 15, fq = lane >> 4;
    const int K = g.K;
    unsigned voffA[2], voffB[2];
#pragma unroll
    for (int i = 0; i < 2; ++i) { int R, C; stage_rc(tid * 16 + i * 8192, R, C); const int Rb = Epi::PERM ? ((R & ~31) + perm32(R & 31)) : R;
        voffA[i] = (unsigned)(R * K + C) * 2u; voffB[i] = (unsigned)(Rb * K + C) * 2u; }
    const size_t kstep = (size_t)(BK * 2);
    const size_t hstep = (size_t)HALF * K * 2;
    const size_t tstep = 2 * hstep;
    const unsigned ldsw = (unsigned)wid * 1024u;
    const int aoff = lds_byte(wr * 64 + fr, fq * 8), boff = lds_byte(wc * 32 + fr, fq * 8);
#define PG8_SA(b, h) (((b) * 2 + (h)) * HTB)
#define PG8_SB(b, h) ((4 + (b) * 2 + (h)) * HTB)
#define PG8_STAGE(bufoff, gbase, voff) do { _Pragma("unroll") for (int _i = 0; _i < 2; ++_i) \
        __builtin_amdgcn_global_load_lds((const unsigned*)((const char*)(gbase) + (voff)[_i]), (PG8_LAS unsigned*)(lds + (bufoff) + ldsw + _i * 8192), 16, 0, 0); } while (0)
#define PG8_LDA(dst, b, h) do { _Pragma("unroll") for (int m = 0; m < 4; ++m) _Pragma("unroll") for (int k = 0; k < 2; ++k) dst[m][k] = *(const PG8_LAS bf16x8*)(lds + PG8_SA(b, h) + aoff + m * 2048 + k * 1024); } while (0)
#define PG8_LDB(dst, b, h) do { _Pragma("unroll") for (int n = 0; n < 2; ++n) _Pragma("unroll") for (int k = 0; k < 2; ++k) dst[n][k] = *(const PG8_LAS bf16x8*)(lds + PG8_SB(b, h) + boff + n * 2048 + k * 1024); } while (0)
#define PG8_MMA(ai, bj, At, Bt) do { __builtin_amdgcn_s_setprio(1); _Pragma("unroll") for (int m = 0; m < 4; ++m) _Pragma("unroll") for (int n = 0; n < 2; ++n) _Pragma("unroll") for (int k = 0; k < 2; ++k) \
        acc[ai][bj][m][n] = __builtin_amdgcn_mfma_f32_16x16x32_bf16(Bt[n][k], At[m][k], acc[ai][bj][m][n], 0, 0, 0); __builtin_amdgcn_s_setprio(0); } while (0)
#define PG8_WAIT_V(n) asm volatile("s_waitcnt vmcnt(" #n ")" ::: "memory")
#define PG8_WAIT_L(n) asm volatile("s_waitcnt lgkmcnt(" #n ")" ::: "memory")
#define PG8_BAR __builtin_amdgcn_s_barrier()
#define PG8_SCHED __builtin_amdgcn_sched_barrier(0)
    Unit cur, nxt; int ui = 0;
    float zf_ = 0.f; asm volatile("" : "+v"(zf_));
    const f32x4 zero4_ = {zf_, zf_, zf_, zf_};
    if (!S.next(0, cur)) return;
    f32x4 acc[2][2][4][2];
#pragma unroll
    for (int a = 0; a < 2; ++a)
#pragma unroll
        for (int b = 0; b < 2; ++b)
#pragma unroll
            for (int m = 0; m < 4; ++m)
#pragma unroll
                for (int n = 0; n < 2; ++n) acc[a][b][m][n] = zero4_;
    bf16x8 At[4][2], B0[2][2], B1[2][2];
    const char* cA = (const char*)g.A + (size_t)cur.pm * tstep + (size_t)cur.kt0 * kstep; const char* cB = (const char*)g.Bt + (size_t)cur.pn * tstep + (size_t)cur.kt0 * kstep;
    S.a_ready(cur);
    if constexpr (SP2) {
        PG8_STAGE(PG8_SB(0, 0), cB, voffB); PG8_STAGE(PG8_SB(0, 1), cB + hstep, voffB); PG8_STAGE(PG8_SA(0, 0), cA, voffA); PG8_STAGE(PG8_SA(0, 1), cA + hstep, voffA);
        if (wr == 1) PG8_BAR;
        PG8_WAIT_V(2); PG8_BAR;
        PG8_STAGE(PG8_SB(1, 0), cB + kstep, voffB); PG8_STAGE(PG8_SA(1, 0), cA + kstep, voffA); PG8_STAGE(PG8_SB(1, 1), cB + hstep + kstep, voffB);
        PG8_WAIT_V(6); PG8_BAR;
    } else {
        PG8_STAGE(PG8_SB(0, 0), cB, voffB); PG8_STAGE(PG8_SA(0, 0), cA, voffA); PG8_STAGE(PG8_SB(0, 1), cB + hstep, voffB); PG8_STAGE(PG8_SA(0, 1), cA + hstep, voffA);
        if (wr == 1) PG8_BAR;
        PG8_WAIT_V(4); PG8_BAR;
        PG8_STAGE(PG8_SB(1, 0), cB + kstep, voffB); PG8_STAGE(PG8_SA(1, 0), cA + kstep, voffA); PG8_STAGE(PG8_SB(1, 1), cB + hstep + kstep, voffB);
        PG8_WAIT_V(6); PG8_BAR;
    }
    for (;;) {
        const bool has_next = S.next(ui + 1, nxt);
        const char* nA = has_next ? (const char*)g.A + (size_t)nxt.pm * tstep + (size_t)nxt.kt0 * kstep : cA; const char* nB = has_next ? (const char*)g.Bt + (size_t)nxt.pn * tstep + (size_t)nxt.kt0 * kstep : cB;
        const int nt = cur.nkt;
        for (int t = 0; t < nt; t += 2) {
            const bool last = (t == nt - 2);
            const char* a1 = cA + (size_t)(t + 1) * kstep;
            const char* a2 = last ? nA : cA + (size_t)(t + 2) * kstep; const char* b2 = last ? nB : cB + (size_t)(t + 2) * kstep;
            const char* a3 = a2 + kstep; const char* b3 = b2 + kstep;
            if (last && has_next) S.a_ready(nxt);
            if constexpr (SP2) {
            PG8_LDB(B0, 0, 0); PG8_LDB(B1, 0, 1); PG8_SCHED; PG8_LDA(At, 0, 0); PG8_STAGE(PG8_SA(1, 1), a1 + hstep, voffA);
            PG8_WAIT_V(8); PG8_WAIT_L(0); PG8_BAR; PG8_MMA(0, 0, At, B0); PG8_MMA(0, 1, At, B1); PG8_BAR; PG8_SCHED;
            PG8_LDA(At, 0, 1); PG8_STAGE(PG8_SB(0, 0), b2, voffB); PG8_STAGE(PG8_SB(0, 1), b2 + hstep, voffB); PG8_STAGE(PG8_SA(0, 0), a2, voffA);
            PG8_WAIT_V(8); PG8_WAIT_L(0); PG8_BAR; PG8_MMA(1, 0, At, B0); PG8_MMA(1, 1, At, B1); PG8_BAR; PG8_SCHED;
            PG8_LDB(B0, 1, 0); PG8_LDB(B1, 1, 1); PG8_SCHED; PG8_LDA(At, 1, 0); PG8_STAGE(PG8_SA(0, 1), a2 + hstep, voffA);
            PG8_WAIT_V(8); PG8_WAIT_L(0); PG8_BAR; PG8_MMA(0, 0, At, B0); PG8_MMA(0, 1, At, B1); PG8_BAR; PG8_SCHED;
            PG8_LDA(At, 1, 1); PG8_STAGE(PG8_SB(1, 0), b3, voffB); PG8_STAGE(PG8_SB(1, 1), b3 + hstep, voffB); PG8_STAGE(PG8_SA(1, 0), a3, voffA);
            PG8_WAIT_V(8); PG8_WAIT_L(0); PG8_BAR; PG8_MMA(1, 0, At, B0); PG8_MMA(1, 1, At, B1); PG8_BAR; PG8_SCHED;
            } else {
            PG8_LDB(B0, 0, 0); PG8_SCHED; PG8_LDA(At, 0, 0); PG8_STAGE(PG8_SA(1, 1), a1 + hstep, voffA);
            PG8_WAIT_L(8); PG8_BAR; PG8_WAIT_L(0); PG8_MMA(0, 0, At, B0); PG8_BAR; PG8_SCHED;
            PG8_LDB(B1, 0, 1); PG8_STAGE(PG8_SB(0, 0), b2, voffB);
            PG8_BAR; PG8_WAIT_L(0); PG8_MMA(0, 1, At, B1); PG8_BAR;
            PG8_LDA(At, 0, 1); PG8_STAGE(PG8_SA(0, 0), a2, voffA);
            PG8_BAR; PG8_WAIT_L(0); PG8_MMA(1, 0, At, B0); PG8_BAR; PG8_SCHED;
            PG8_STAGE(PG8_SB(0, 1), b2 + hstep, voffB);
            PG8_WAIT_V(6); PG8_BAR; PG8_MMA(1, 1, At, B1); PG8_BAR;
            PG8_LDB(B0, 1, 0); PG8_SCHED; PG8_LDA(At, 1, 0); PG8_STAGE(PG8_SA(0, 1), a2 + hstep, voffA);
            PG8_WAIT_L(8); PG8_BAR; PG8_WAIT_L(0); PG8_MMA(0, 0, At, B0); PG8_BAR; PG8_SCHED;
            PG8_LDB(B1, 1, 1); PG8_STAGE(PG8_SB(1, 0), b3, voffB);
            PG8_BAR; PG8_WAIT_L(0); PG8_MMA(0, 1, At, B1); PG8_BAR;
            PG8_LDA(At, 1, 1); PG8_STAGE(PG8_SA(1, 0), a3, voffA);
            PG8_BAR; PG8_WAIT_L(0); PG8_MMA(1, 0, At, B0); PG8_BAR; PG8_SCHED;
            PG8_STAGE(PG8_SB(1, 1), b3 + hstep, voffB);
            PG8_WAIT_V(6); PG8_BAR; PG8_MMA(1, 1, At, B1); PG8_BAR;
            }
        }
        if constexpr (ALIGN_EPI) { if (wr == 0) PG8_BAR; }
        if constexpr (!Epi::AFTER_DRAIN) { E(acc, cur, wr, wc, fr, fq); S.done(cur); }
        if (!has_next) break;
#pragma unroll
        for (int a = 0; a < 2; ++a)
#pragma unroll
            for (int b = 0; b < 2; ++b)
#pragma unroll
                for (int m = 0; m < 4; ++m)
#pragma unroll
                    for (int n = 0; n < 2; ++n) acc[a][b][m][n] = zero4_;
        cur = nxt; cA = nA; cB = nB; ++ui;
        if constexpr (ALIGN_EPI) { if (wr == 1) PG8_BAR; }
    }
    PG8_WAIT_V(0);
    if constexpr (!ALIGN_EPI) { if (wr == 0) PG8_BAR; }
    PG8_BAR;
    if constexpr (Epi::AFTER_DRAIN) { E.fused(acc, cur, wr, wc, fr, fq, lds, wid, lane); S.done(cur); }
#undef PG8_SA
#undef PG8_SB
#undef PG8_STAGE
#undef PG8_LDA
#undef PG8_LDB
#undef PG8_MMA
#undef PG8_WAIT_V
#undef PG8_WAIT_L
#undef PG8_BAR
#undef PG8_SCHED
}
}

#ifndef PG8_SP2
#define PG8_SP2 true
#endif

constexpr int DM = 1024, NB = 8, SEQ = 2048, NMETA = 16, DEPTH = 2, DBATCH = 128, DSEQ = 8, NH = 8, HD = 128, DFF = 2816, NIN = 9216;
constexpr int R_META = NB * SEQ;
constexpr int R_SAMP = R_META + NB * NMETA;
constexpr int M_REAL = R_SAMP + DBATCH * DSEQ;
constexpr int MP = 17664;
constexpr int NPOS = SEQ + NMETA + DSEQ;
constexpr float EPS = 1e-6f;
constexpr int NWAVES = 8, NTHREADS = 512;
constexpr int LDS_BYTES = 147456;
constexpr int CO_NU = (MP / 256) * (DM / 256), CO_LO = CO_NU - 256 > 0 ? CO_NU - 256 : 0, CO_HI = CO_LO + (CO_NU - (256 - NB * NH));
constexpr size_t O_YP = 0, O_YS = (size_t)NB * SEQ * DM, O_SRP = O_YS + (size_t)DBATCH * DSEQ * DM, O_SCP = O_SRP + (size_t)DEPTH * NB * NH * HD * HD,
                 O_SRS = O_SCP + (size_t)DEPTH * NB * 2 * DM, O_SCS = O_SRS + (size_t)DEPTH * DBATCH * NH * HD * HD, O_END = O_SCS + (size_t)DEPTH * DBATCH * 2 * DM;
constexpr size_t MiB = 1u << 20;
constexpr size_t WS_TAB = 0, WS_W = 2 * MiB;
constexpr size_t W_IN = 0, W_RET = (size_t)NIN * DM * 2, W_CONV = W_RET + (size_t)DM * DM * 2, W_O = W_CONV + (size_t)DM * DM * 2, W_GU = W_O + (size_t)DM * DM * 2,
                 W_DN = W_GU + (size_t)2 * DFF * DM * 2, W_LAYER = W_DN + (size_t)DFF * DM * 2;
constexpr size_t ROWBUF = (size_t)MP * DM * 2;
constexpr size_t WS_XN = WS_W + DEPTH * W_LAYER, WS_H = WS_XN + ROWBUF, WS_P = WS_H + 2 * ROWBUF, WS_END = WS_P + 8 * ROWBUF;
constexpr size_t WS_CTL = 3 * (MiB / 2);
static_assert((size_t)NPOS * 64 * 8 <= WS_CTL, "rope table fits");
static_assert((size_t)MP * DFF * 2 <= 3 * ROWBUF, "ACT overlays K|V|G");
static_assert((size_t)11 * (MP - R_META) * DM * 4 <= 2 * ROWBUF, "K-slice partial sums overlay GA|GB (dead after the gated out-projections)");

#define LAS __attribute__((address_space(3)))
typedef unsigned short bf16;
typedef pg8::f32x4 f32x4;
typedef pg8::u32x4 u32x4;
typedef pg8::u32x2 u32x2;
typedef pg8::bf16x8 bf16x8;
typedef float f32x2 __attribute__((ext_vector_type(2)));
using pg8::bflo; using pg8::bfhi; using pg8::cvt_pk_bf16;

__device__ const float ROPE_INV[64] = {
1.000000000e+00f, 8.659643531e-01f, 7.498942614e-01f, 6.493816376e-01f, 5.623413324e-01f, 4.869675338e-01f, 4.216965139e-01f, 3.651741147e-01f, 3.162277639e-01f, 2.738419771e-01f, 2.371373773e-01f, 2.053525001e-01f, 1.778279394e-01f, 1.539926529e-01f, 1.333521307e-01f, 1.154782027e-01f, 1.000000015e-01f, 8.659642935e-02f, 7.498941571e-02f, 6.493816525e-02f, 5.623413250e-02f, 4.869675264e-02f, 4.216965288e-02f, 3.651741147e-02f, 3.162277490e-02f, 2.738419734e-02f, 2.371373773e-02f, 2.053525113e-02f, 1.778279431e-02f, 1.539926510e-02f, 1.333521493e-02f, 1.154782064e-02f, 9.999999776e-03f, 8.659643121e-03f, 7.498941850e-03f, 6.493816152e-03f, 5.623413250e-03f, 4.869675264e-03f, 4.216964822e-03f, 3.651741194e-03f, 3.162277630e-03f, 2.738419687e-03f, 2.371373586e-03f, 2.053524833e-03f, 1.778279431e-03f, 1.539926510e-03f, 1.333521446e-03f, 1.154781901e-03f, 1.000000047e-03f, 8.659643354e-04f, 7.498942432e-04f, 6.493816618e-04f, 5.623413017e-04f, 4.869675322e-04f, 4.216965172e-04f, 3.651741426e-04f, 3.162277571e-04f, 2.738419571e-04f, 2.371373703e-04f, 2.053525095e-04f, 1.778279402e-04f, 1.539926452e-04f, 1.333521504e-04f, 1.154782003e-04f };
__device__ const float LOG_GAMMA[8] = { -3.174869716e-02f, -1.574835740e-02f, -7.843177766e-03f, -3.913899418e-03f, -1.955034910e-03f, -9.770396864e-04f, -4.884005175e-04f, -2.441704273e-04f };

__device__ __forceinline__ float wave_sum(float v) {
#pragma unroll
    for (int o = 1; o < 64; o <<= 1) v += __shfl_xor(v, o);
    return v;
}
#define LDS_WAIT() asm volatile("s_waitcnt lgkmcnt(0)" ::: "memory")

struct Args { const float* in[15]; float* out; unsigned char* ws; int ph_lo, ph_hi; };
__device__ __forceinline__ int bxl() { int b = blockIdx.x; asm volatile("" : "+s"(b)); return b; }
typedef const __attribute__((address_space(4))) Args* ArgP;
__device__ __forceinline__ ArgP argp() { ArgP p = (ArgP)__builtin_amdgcn_kernarg_segment_ptr(); asm volatile("" : "+s"(p)); return p; }
enum { I_XP = 0, I_XS, I_SRET, I_SCONV, I_META, I_NMG, I_WIN, I_CONVW, I_WRET, I_WCONV, I_WO, I_NFG, I_WGU, I_WDN, I_FNG };

__device__ __forceinline__ void p0_transpose_item(const float* W, int K, int N, bf16* WT, int dst_row0, LAS float* scr, int k0, int n0, int lane) {
#pragma unroll 8
    for (int i = 0; i < 32; ++i) { const int kk = 2 * i + (lane >> 5); scr[kk * 33 + (lane & 31)] = W[(size_t)(k0 + kk) * N + n0 + (lane & 31)]; }
    LDS_WAIT(); asm volatile("" ::: "memory");
    const int c = lane & 7;
#pragma unroll
    for (int j = 0; j < 4; ++j) { const int n = (lane >> 3) + 8 * j; const LAS float* s = scr + (8 * c) * 33 + n;
        u32x4 o; o.x = cvt_pk_bf16(s[0 * 33], s[1 * 33]); o.y = cvt_pk_bf16(s[2 * 33], s[3 * 33]); o.z = cvt_pk_bf16(s[4 * 33], s[5 * 33]); o.w = cvt_pk_bf16(s[6 * 33], s[7 * 33]);
        *(u32x4*)(WT + (size_t)(dst_row0 + n) * K + k0 + 8 * c) = o; }
    LDS_WAIT(); asm volatile("" ::: "memory");
}
__device__ __forceinline__ int map_in(int n0) {
    const int seg = n0 >> 10, j = n0 & 1023;
    if (seg < 2) { const int X = j >> 7, d = j & 127; return seg * 1024 + (X >> 1) * 256 + (d >> 6) * 128 + (X & 1) * 64 + (d & 63); }
    if (seg == 5) return 5120 + (j >> 7) * 256 + (j & 127);
    if (seg == 6) return 5120 + (j >> 7) * 256 + 128 + (j & 127);
    return n0;
}
__device__ __forceinline__ int map_gu(int n0) {
    if (n0 < DFF) return (n0 >> 7) * 256 + (n0 & 127);
    const int j = n0 - DFF; return (j >> 7) * 256 + 128 + (j & 127);
}
__device__ __forceinline__ void sincos_d(double r, double& s, double& c) {
    const double r2 = r * r;
    double ts = 1.0, tc = 1.0, ss = 1.0, cc = 1.0;
#pragma unroll
    for (int n = 1; n <= 15; ++n) { tc *= -r2 / (double)((2 * n - 1) * (2 * n)); ts *= -r2 / (double)((2 * n) * (2 * n + 1)); cc += tc; ss += ts; }
    s = ss * r; c = cc;
}

__device__ __forceinline__ void rms_row(const f32x4 (&v)[4], const float* g, int lane, float& rs, f32x4 (&y)[4]) {
    float s = 0.f;
#pragma unroll
    for (int j = 0; j < 4; ++j) s += (v[j].x * v[j].x + v[j].y * v[j].y) + (v[j].z * v[j].z + v[j].w * v[j].w);
    rs = __builtin_amdgcn_rsqf(wave_sum(s) * (1.f / DM) + EPS);
#pragma unroll
    for (int j = 0; j < 4; ++j) { const f32x4 gv = *((const f32x4*)g + lane + 64 * j); y[j] = v[j] * rs * gv; }
}
__device__ __forceinline__ void load_bf16_row(const bf16* row, int lane, f32x4 (&v)[4]) {
    const u32x2* p = (const u32x2*)row + lane;
#pragma unroll
    for (int j = 0; j < 4; ++j) { const u32x2 w = p[64 * j]; v[j] = (f32x4){bflo(w.x), bfhi(w.x), bflo(w.y), bfhi(w.y)}; }
}
__device__ __forceinline__ void store_bf16_row(bf16* orow, int lane, const f32x4 (&y)[4]) {
    u32x2* o8 = (u32x2*)orow + lane;
#pragma unroll
    for (int j = 0; j < 4; ++j) { u32x2 w; w.x = cvt_pk_bf16(y[j].x, y[j].y); w.y = cvt_pk_bf16(y[j].z, y[j].w); o8[64 * j] = w; }
}

constexpr int IT_IN = (DM / 64) * (NIN / 32), IT_SQ = (DM / 64) * (DM / 32), IT_GU = (DM / 64) * (2 * DFF / 32), IT_DN = (DFF / 64) * (DM / 32);
constexpr int IT_LAYER = IT_IN + 3 * IT_SQ + IT_GU + IT_DN;
__device__ __forceinline__ void convert_weights(ArgP a, LAS float* scr, int lane, int first, int count, int gw, int NGW) {
    unsigned char* ws = a->ws;
    for (int it0 = gw; it0 < count; it0 += NGW) {
        const int it = first + it0;
        const int l = it / IT_LAYER; int r = it - l * IT_LAYER;
        unsigned char* wl = ws + WS_W + (size_t)l * W_LAYER;
        if (r < IT_IN) { const int nblk = NIN / 32, kb = r / nblk, nb = r % nblk; p0_transpose_item(a->in[I_WIN] + (size_t)l * DM * NIN, DM, NIN, (bf16*)(wl + W_IN), map_in(nb * 32), scr, kb * 64, nb * 32, lane); continue; } r -= IT_IN;
        if (r < 3 * IT_SQ) { const int which = r / IT_SQ; r -= which * IT_SQ; const int nblk = DM / 32, kb = r / nblk, nb = r % nblk;
            const float* W = (which == 0 ? a->in[I_WRET] : which == 1 ? a->in[I_WCONV] : a->in[I_WO]) + (size_t)l * DM * DM;
            bf16* WT = (bf16*)(wl + (which == 0 ? W_RET : which == 1 ? W_CONV : W_O));
            p0_transpose_item(W, DM, DM, WT, nb * 32, scr, kb * 64, nb * 32, lane); continue; } r -= 3 * IT_SQ;
        if (r < IT_GU) { const int nblk = 2 * DFF / 32, kb = r / nblk, nb = r % nblk; p0_transpose_item(a->in[I_WGU] + (size_t)l * DM * 2 * DFF, DM, 2 * DFF, (bf16*)(wl + W_GU), map_gu(nb * 32), scr, kb * 64, nb * 32, lane); continue; } r -= IT_GU;
        { const int nblk = DM / 32, kb = r / nblk, nb = r % nblk; p0_transpose_item(a->in[I_WDN] + (size_t)l * DFF * DM, DFF, DM, (bf16*)(wl + W_DN), nb * 32, scr, kb * 64, nb * 32, lane); }
    }
}

__device__ __forceinline__ void p0_prologue(ArgP a, LAS unsigned char* lds, int G) {
    int tid_ = threadIdx.x; asm volatile("" : "+v"(tid_));
    const int tid = tid_, lane = tid & 63, wave = tid >> 6;
    LAS float* scr = (LAS float*)(lds + wave * 16384);
    const int gw = blockIdx.x * NWAVES + wave, NGW = G * NWAVES;
    unsigned char* ws = a->ws;
    convert_weights(a, scr, lane, 0, IT_IN, gw, NGW);
    convert_weights(a, scr, lane, IT_IN, 2 * IT_SQ, gw, NGW);
    {
        f32x2* tab = (f32x2*)(ws + WS_TAB);
        for (int idx = blockIdx.x * NTHREADS + tid; idx < NPOS * 64; idx += G * NTHREADS) {
            const int p = idx >> 6, i = idx & 63;
            const float pos = (float)(p < SEQ + NMETA ? p : 16384 + (p - (SEQ + NMETA)));
            const float ang = pos * ROPE_INV[i];
            const double ad = (double)ang;
            const double k = __builtin_rint(ad * 0.15915494309189535);
            double r = __builtin_fma(-k, 6.283185307179586, ad); r = __builtin_fma(-k, 2.4492935982947064e-16, r);
            double s, c; sincos_d(r, s, c);
            tab[idx] = (f32x2){(float)c, (float)s};
        }
    }
    bf16* H = (bf16*)(ws + WS_H); bf16* XN = (bf16*)(ws + WS_XN);
    for (int m = gw; m < MP; m += NGW) {
        f32x4 v[4];
        if (m < M_REAL) {
            const float* src = m < R_META ? a->in[I_XP] + (size_t)m * DM : m < R_SAMP ? a->in[I_META] + (size_t)((m - R_META) & 15) * DM : a->in[I_XS] + (size_t)(m - R_SAMP) * DM;
#pragma unroll
            for (int j = 0; j < 4; ++j) v[j] = *((const f32x4*)src + lane + 64 * j);
        } else {
#pragma unroll
            for (int j = 0; j < 4; ++j) { float z = 0.f; asm volatile("" : "+v"(z)); v[j] = (f32x4){z, z, z, z}; }
        }
        if (m >= R_META) store_bf16_row(H + (size_t)m * DM, lane, v);
        float rs; f32x4 y[4]; rms_row(v, a->in[I_NMG], lane, rs, y);
        store_bf16_row(XN + (size_t)m * DM, lane, y);
    }
}

template <int NSLICE> __device__ __forceinline__ void rms_phase(ArgP a, const float* g, bool final_out, int G) {
    int tid_ = threadIdx.x; asm volatile("" : "+v"(tid_));
    const int tid = tid_, lane = tid & 63, wave = tid >> 6;
    const int gw = blockIdx.x * NWAVES + wave, NGW = G * NWAVES;
    bf16* H = (bf16*)(a->ws + WS_H); bf16* XN = (bf16*)(a->ws + WS_XN);
    for (int m = gw; m < R_META; m += 2 * NGW) {
        const int m2 = m + NGW; const bool has2 = m2 < R_META;
        f32x4 v[4], u[4];
        load_bf16_row(H + (size_t)m * DM, lane, v); load_bf16_row(H + (size_t)(has2 ? m2 : m) * DM, lane, u);
        float rs; f32x4 y[4];
        rms_row(v, g, lane, rs, y);
        if (!final_out) store_bf16_row(XN + (size_t)m * DM, lane, y);
        else { float* o = a->out + O_YP + (size_t)m * DM;
#pragma unroll
            for (int j = 0; j < 4; ++j) *((f32x4*)o + lane + 64 * j) = y[j]; }
        if (has2) {
            rms_row(u, g, lane, rs, y);
            if (!final_out) store_bf16_row(XN + (size_t)m2 * DM, lane, y);
            else { float* o = a->out + O_YP + (size_t)m2 * DM;
#pragma unroll
                for (int j = 0; j < 4; ++j) *((f32x4*)o + lane + 64 * j) = y[j]; }
        }
    }
    for (int t = (NGW - 1 - gw); t < M_REAL - R_META; t += NGW) {
        const int m = R_META + t;
        if (final_out && m < R_SAMP) continue;
        f32x4 v[4]; load_bf16_row(H + (size_t)m * DM, lane, v);
        const bf16* PART = (const bf16*)(a->ws + WS_P + 6 * ROWBUF) + (size_t)t * DM;
#pragma unroll
        for (int sl = 0; sl < NSLICE; ++sl) {
            f32x4 pv[4]; load_bf16_row(PART + (size_t)sl * (MP - R_META) * DM, lane, pv);
#pragma unroll
            for (int j = 0; j < 4; ++j) v[j] = v[j] + pv[j];
        }
        if (!final_out) store_bf16_row(H + (size_t)m * DM, lane, v);
        float rs; f32x4 y[4]; rms_row(v, g, lane, rs, y);
        if (!final_out) store_bf16_row(XN + (size_t)m * DM, lane, y);
        else { float* o = a->out + O_YS + (size_t)(m - R_SAMP) * DM;
#pragma unroll
            for (int j = 0; j < 4; ++j) *((f32x4*)o + lane + 64 * j) = y[j]; }
    }
}

constexpr int PT = 136, PTB = PT * 2;
constexpr int RG0 = 0, RG1 = 128 * PTB, RG2 = 2 * RG1, RG3 = 3 * RG1, RG4 = 4 * RG1;
static_assert(RG4 + 128 * 4 * 8 <= LDS_BYTES, "retention LDS map");
__device__ __forceinline__ bf16x8 ldfrag(LAS unsigned char* base, int row, int kel) { return *(const LAS bf16x8*)(base + row * PTB + kel * 2); }
#define MFMA16(a, b, c) __builtin_amdgcn_mfma_f32_16x16x32_bf16((a), (b), (c), 0, 0, 0)

#ifndef CHAIN_GPRE
#define CHAIN_GPRE 1
#endif
#define CHAIN_BAR() do { asm volatile("s_waitcnt lgkmcnt(0)" ::: "memory"); __builtin_amdgcn_s_barrier(); asm volatile("" ::: "memory"); } while (0)
typedef short s16x4 __attribute__((ext_vector_type(4)));
__device__ __forceinline__ bf16x8 ldfrag_tr(LAS unsigned char* base, int k0, int n0, int l15, int quad) {
    LAS unsigned char* p = base + (k0 + 8 * quad + (l15 >> 2)) * PTB + (n0 + 4 * (l15 & 3)) * 2;
    const s16x4 lo = __builtin_amdgcn_ds_read_tr16_b64_v4i16((LAS s16x4*)p);
    const s16x4 hi = __builtin_amdgcn_ds_read_tr16_b64_v4i16((LAS s16x4*)(p + 4 * PTB));
    return (bf16x8){lo[0], lo[1], lo[2], lo[3], hi[0], hi[1], hi[2], hi[3]};
}

template <bool STORE> __device__ __forceinline__ void ret_chain(LAS unsigned char* lds, int b, int h, bf16* Qb, const bf16* Kb, const bf16* Vb, const bf16* Gb, const f32x2* tab, float* s_out) {
    int tid_ = threadIdx.x; asm volatile("" : "+v"(tid_));
    const int tid = tid_, lane = tid & 63, w = tid >> 6, wr = w >> 2, wc = w & 3, l15 = lane & 15, quad = lane >> 4;
    const float lg = LOG_GAMMA[h];
    float zf_ = 0.f; asm volatile("" : "+v"(zf_)); const f32x4 zero4 = {zf_, zf_, zf_, zf_}; const u32x4 zero4u = __builtin_bit_cast(u32x4, zero4);
    f32x4 acc_s[4][2];
#pragma unroll
    for (int x = 0; x < 4; ++x)
#pragma unroll
        for (int y = 0; y < 2; ++y) acc_s[x][y] = zero4;
    for (int idx = tid; idx < 128 * PTB / 16; idx += NTHREADS) *(LAS u32x4*)(lds + RG3 + idx * 16) = zero4u;
    u32x4 rq[4], rk[4], rv[4];
#define CHAIN_LOAD(ci_) do { const int Leff_ = (ci_) == 0 ? NMETA : 128; const int rb_ = (ci_) == 0 ? (R_META + b * NMETA) : (b * SEQ + ((ci_) - 1) * 128); \
        _Pragma("unroll") for (int it = 0; it < 4; ++it) { const int item = tid + NTHREADS * it, j = item >> 4, c = item & 15; \
            const size_t goff = (size_t)(rb_ + (j < Leff_ ? j : 0)) * DM + h * HD + 8 * c; \
            rq[it] = *(const u32x4*)(Qb + goff); rk[it] = *(const u32x4*)(Kb + goff); rv[it] = *(const u32x4*)(Vb + goff); } } while (0)
    CHAIN_LOAD(0);
    for (int ci = 0; ci < 17; ++ci) {
        const int Leff = ci == 0 ? NMETA : 128;
        const int row_base = ci == 0 ? (R_META + b * NMETA) : (b * SEQ + (ci - 1) * 128);
#pragma unroll
        for (int it = 0; it < 4; ++it) {
            const int item = tid + NTHREADS * it, j = item >> 4, c = item & 15;
            const bool valid = j < Leff;
            const float kd = valid ? __expf(lg * (float)(Leff - 1 - j)) : 0.f;
            const u32x4 q = valid ? rq[it] : zero4u, k = valid ? rk[it] : zero4u, v = rv[it];
            u32x4 vs;
#pragma unroll
            for (int p = 0; p < 4; ++p) vs[p] = cvt_pk_bf16(bflo(v[p]) * kd, bfhi(v[p]) * kd);
            const int boff = j * PTB + (8 * c) * 2;
            *(LAS u32x4*)(lds + RG0 + boff) = q; *(LAS u32x4*)(lds + RG1 + boff) = k; *(LAS u32x4*)(lds + RG2 + boff) = vs;
        }
        CHAIN_BAR();
        if (ci + 1 < 17) CHAIN_LOAD(ci + 1);
        f32x4 acc_p[4][2], acc_o[4][2];
#pragma unroll
        for (int x = 0; x < 4; ++x)
#pragma unroll
            for (int y = 0; y < 2; ++y) { acc_p[x][y] = zero4; acc_o[x][y] = zero4; }
#pragma unroll
        for (int ks = 0; ks < 4; ++ks) {
            const int kel = ks * 32 + quad * 8;
            bf16x8 qf[4], kf[2], sf[2];
#pragma unroll
            for (int ti = 0; ti < 4; ++ti) qf[ti] = ldfrag(lds + RG0, 64 * wr + 16 * ti + l15, kel);
#pragma unroll
            for (int t = 0; t < 2; ++t) { kf[t] = ldfrag(lds + RG1, 32 * wc + 16 * t + l15, kel); sf[t] = ldfrag(lds + RG3, 32 * wc + 16 * t + l15, kel); }
#pragma unroll
            for (int ti = 0; ti < 4; ++ti)
#pragma unroll
                for (int t = 0; t < 2; ++t) { if (32 * wc + 16 * t <= 64 * wr + 16 * ti + 15) acc_p[ti][t] = MFMA16(kf[t], qf[ti], acc_p[ti][t]);
                    acc_o[ti][t] = MFMA16(sf[t], qf[ti], acc_o[ti][t]); }
        }
        CHAIN_BAR();
        {
            const float pscale = __expf(-lg * (float)Leff);
#pragma unroll
            for (int ti = 0; ti < 4; ++ti)
#pragma unroll
                for (int t = 0; t < 2; ++t) {
                    const int i = 64 * wr + 16 * ti + l15, jb = 32 * wc + 16 * t + 4 * quad;
                    float p[4];
#pragma unroll
                    for (int r = 0; r < 4; ++r) p[r] = (jb + r <= i) ? acc_p[ti][t][r] * pscale : 0.f;
                    u32x2 wv; wv.x = cvt_pk_bf16(p[0], p[1]); wv.y = cvt_pk_bf16(p[2], p[3]);
                    *(LAS u32x2*)(lds + RG0 + i * PTB + jb * 2) = wv;
                }
        }
        CHAIN_BAR();
#if CHAIN_GPRE
        u32x2 gpre[4][2];
#pragma unroll
        for (int ti = 0; ti < 4; ++ti) { const int i = 64 * wr + 16 * ti + l15; const size_t roff = (size_t)(row_base + (i < Leff ? i : 0)) * DM + h * HD;
#pragma unroll
            for (int t = 0; t < 2; ++t) gpre[ti][t] = *(const u32x2*)(Gb + roff + 32 * wc + 16 * t + 4 * quad); }
#endif
        {
            const float sdec = __expf(lg * (float)Leff);
#pragma unroll
            for (int x = 0; x < 4; ++x)
#pragma unroll
                for (int y = 0; y < 2; ++y) acc_s[x][y] = acc_s[x][y] * sdec;
        }
#pragma unroll
        for (int ks = 0; ks < 4; ++ks) {
            const int kel = ks * 32 + quad * 8;
            bf16x8 pf[4], ktf[4], vf[2];
#pragma unroll
            for (int ti = 0; ti < 4; ++ti) { pf[ti] = ldfrag(lds + RG0, 64 * wr + 16 * ti + l15, kel); ktf[ti] = ldfrag_tr(lds + RG1, ks * 32, 64 * wr + 16 * ti, l15, quad); }
#pragma unroll
            for (int t = 0; t < 2; ++t) vf[t] = ldfrag_tr(lds + RG2, ks * 32, 32 * wc + 16 * t, l15, quad);
#pragma unroll
            for (int ti = 0; ti < 4; ++ti)
#pragma unroll
                for (int t = 0; t < 2; ++t) { if (32 * ks <= 64 * wr + 16 * ti + 15) acc_o[ti][t] = MFMA16(vf[t], pf[ti], acc_o[ti][t]);
                    acc_s[ti][t] = MFMA16(ktf[ti], vf[t], acc_s[ti][t]); }
        }
        LAS f32x2* stats = (LAS f32x2*)(lds + RG4);
#pragma unroll
        for (int ti = 0; ti < 4; ++ti) {
            float s = 0.f, q = 0.f;
#pragma unroll
            for (int t = 0; t < 2; ++t)
#pragma unroll
                for (int r = 0; r < 4; ++r) { const float x = acc_o[ti][t][r]; s += x; q += x * x; }
            s += __shfl_xor(s, 16); s += __shfl_xor(s, 32); q += __shfl_xor(q, 16); q += __shfl_xor(q, 32);
            if (quad == 0) stats[(64 * wr + 16 * ti + l15) * 4 + wc] = (f32x2){s, q};
        }
#pragma unroll
        for (int td = 0; td < 4; ++td)
#pragma unroll
            for (int t = 0; t < 2; ++t) {
                const int e = 32 * wc + 16 * t + l15, d = 64 * wr + 16 * td + 4 * quad;
                u32x2 wv; wv.x = cvt_pk_bf16(acc_s[td][t][0], acc_s[td][t][1]); wv.y = cvt_pk_bf16(acc_s[td][t][2], acc_s[td][t][3]);
                *(LAS u32x2*)(lds + RG3 + e * PTB + d * 2) = wv;
            }
        CHAIN_BAR();
#pragma unroll
        for (int ti = 0; ti < 4; ++ti) {
            const int i = 64 * wr + 16 * ti + l15;
            if (STORE && i < Leff) {
                const f32x2 s0 = stats[i * 4 + 0], s1 = stats[i * 4 + 1], s2 = stats[i * 4 + 2], s3 = stats[i * 4 + 3];
                const float mean = ((s0.x + s1.x) + (s2.x + s3.x)) * (1.f / HD);
                const float var = fmaxf(((s0.y + s1.y) + (s2.y + s3.y)) * (1.f / HD) - mean * mean, 0.f);
                const float cinv = __expf(-lg * (float)(i + 1));
                const float rstd = __builtin_amdgcn_rsqf(var + EPS * cinv * cinv);
                const size_t roff = (size_t)(row_base + i) * DM + h * HD;
#pragma unroll
                for (int t = 0; t < 2; ++t) {
                    const int e0 = 32 * wc + 16 * t + 4 * quad;
#if CHAIN_GPRE
                    const u32x2 gw = gpre[ti][t];
#else
                    const u32x2 gw = *(const u32x2*)(Gb + roff + e0);
#endif
                    u32x2 wv;
                    wv.x = cvt_pk_bf16(bflo(gw.x) * (acc_o[ti][t][0] - mean) * rstd, bfhi(gw.x) * (acc_o[ti][t][1] - mean) * rstd);
                    wv.y = cvt_pk_bf16(bflo(gw.y) * (acc_o[ti][t][2] - mean) * rstd, bfhi(gw.y) * (acc_o[ti][t][3] - mean) * rstd);
                    *(u32x2*)(Qb + roff + e0) = wv;
                }
            }
        }
    }
#undef CHAIN_LOAD
    if (STORE)
#pragma unroll
    for (int td = 0; td < 4; ++td)
#pragma unroll
        for (int t = 0; t < 2; ++t)
#pragma unroll
            for (int r = 0; r < 4; ++r) s_out[(size_t)(64 * wr + 16 * td + 4 * quad + r) * HD + 32 * wc + 16 * t + l15] = acc_s[td][t][r];
    __syncthreads();
}

template <bool STORE> __device__ __forceinline__ void ret_sample_item(LAS unsigned char* lds, int db, int h, bf16* Qb, const bf16* Kb, const bf16* Vb, const bf16* Gb, const f32x2* tab, const float* s_in, float* s_out) {
    int tid_ = threadIdx.x; asm volatile("" : "+v"(tid_));
    const int tid = tid_, lane = tid & 63, w = tid >> 6;
    LAS float* qT = (LAS float*)lds;
    LAS float* kT = qT + 1024;
    LAS float* vS = kT + 1024;
    LAS float* sc = vS + 1024;
    LAS float* red = sc + 64;
    const float lg = LOG_GAMMA[h];
    const int row0 = R_SAMP + db * DSEQ;
    const int e4 = (tid & 31) * 4, dg = tid >> 5;
    f32x4 st[8];
    {
        const float* sp = s_in + (size_t)(dg * 8) * HD + e4;
#pragma unroll
        for (int dl = 0; dl < 8; ++dl) st[dl] = *(const f32x4*)(sp + (size_t)dl * HD);
    }
    {
        const int i = tid >> 6, dd = tid & 63;
        const size_t goff = (size_t)(row0 + i) * DM + h * HD + dd;
        const float q1 = __builtin_bit_cast(float, (unsigned)Qb[goff] << 16), q2 = __builtin_bit_cast(float, (unsigned)Qb[goff + 64] << 16);
        const float k1 = __builtin_bit_cast(float, (unsigned)Kb[goff] << 16), k2 = __builtin_bit_cast(float, (unsigned)Kb[goff + 64] << 16);
        const float kdsc = __expf(lg * (float)(DSEQ - 1 - i));
        qT[dd * 8 + i] = q1; qT[(dd + 64) * 8 + i] = q2;
        kT[dd * 8 + i] = k1 * kdsc; kT[(dd + 64) * 8 + i] = k2 * kdsc;
#pragma unroll
        for (int t = 0; t < 2; ++t) { const int idx = tid + NTHREADS * t, vi = idx >> 7, ve = idx & 127; vS[idx] = __builtin_bit_cast(float, (unsigned)Vb[(size_t)(row0 + vi) * DM + h * HD + ve] << 16); }
    }
    __syncthreads();
    {
        const int i = w, j = lane & 7, g = lane >> 3; float s = 0.f;
#pragma unroll
        for (int dl = 0; dl < 16; ++dl) { const int d = g * 16 + dl; s += qT[d * 8 + i] * kT[d * 8 + j]; }
        s += __shfl_xor(s, 8); s += __shfl_xor(s, 16); s += __shfl_xor(s, 32);
        if (g == 0) sc[i * 8 + j] = (j <= i) ? s * __expf(lg * (float)(i - (DSEQ - 1))) : 0.f;
    }
    {
        f32x4 vv[8], cr[8];
#pragma unroll
        for (int j = 0; j < 8; ++j) { vv[j] = *(const LAS f32x4*)(vS + j * 128 + e4); cr[j] = (f32x4){0.f, 0.f, 0.f, 0.f}; }
        const float g8 = __expf(lg * (float)DSEQ);
        float* op = s_out + (size_t)(dg * 8) * HD + e4;
#pragma unroll
        for (int dl = 0; dl < 8; ++dl) {
            const int d = dg * 8 + dl; const f32x4 s = st[dl];
            const f32x4 qa = *(const LAS f32x4*)(qT + d * 8), qb = *(const LAS f32x4*)(qT + d * 8 + 4);
            const f32x4 ka = *(const LAS f32x4*)(kT + d * 8), kb = *(const LAS f32x4*)(kT + d * 8 + 4);
            cr[0] += s * qa.x; cr[1] += s * qa.y; cr[2] += s * qa.z; cr[3] += s * qa.w; cr[4] += s * qb.x; cr[5] += s * qb.y; cr[6] += s * qb.z; cr[7] += s * qb.w;
            f32x4 sn = s * g8;
            sn += vv[0] * ka.x; sn += vv[1] * ka.y; sn += vv[2] * ka.z; sn += vv[3] * ka.w; sn += vv[4] * kb.x; sn += vv[5] * kb.y; sn += vv[6] * kb.z; sn += vv[7] * kb.w;
            if (STORE) *(f32x4*)(op + (size_t)dl * HD) = sn;
        }
#pragma unroll
        for (int i = 0; i < 8; ++i) *(LAS f32x4*)(red + (dg * 8 + i) * 128 + e4) = cr[i];
    }
    __syncthreads();
    {
        const int i = w; float o[2];
#pragma unroll
        for (int t = 0; t < 2; ++t) {
            const int e = lane + 64 * t;
            float cr = 0.f;
#pragma unroll
            for (int g = 0; g < 16; ++g) cr += red[(g * 8 + i) * 128 + e];
            float x = cr * __expf(lg * (float)(i + 1));
#pragma unroll
            for (int j = 0; j < 8; ++j) x += sc[i * 8 + j] * vS[j * 128 + e];
            o[t] = x;
        }
        const float mean = wave_sum(o[0] + o[1]) * (1.f / HD);
        const float d0 = o[0] - mean, d1 = o[1] - mean;
        const float var = wave_sum(d0 * d0 + d1 * d1) * (1.f / HD);
        const float rstd = __builtin_amdgcn_rsqf(var + EPS);
        const size_t roff = (size_t)(row0 + i) * DM + h * HD;
        const float g0 = __builtin_bit_cast(float, (unsigned)Gb[roff + lane] << 16), g1 = __builtin_bit_cast(float, (unsigned)Gb[roff + lane + 64] << 16);
        if (STORE) { Qb[roff + lane] = (bf16)(cvt_pk_bf16(g0 * d0 * rstd, 0.f) & 0xffffu);
        Qb[roff + lane + 64] = (bf16)(cvt_pk_bf16(g1 * d1 * rstd, 0.f) & 0xffffu); }
        else if (g0 * d0 * rstd + g1 * d1 * rstd == 12345.678f) Qb[roff + lane] = 0;
    }
    __syncthreads();
}

__device__ __forceinline__ void ld8(const bf16* p, float (&x)[8]) { const u32x4 w = *(const u32x4*)p; x[0] = bflo(w.x); x[1] = bfhi(w.x); x[2] = bflo(w.y); x[3] = bfhi(w.y); x[4] = bflo(w.z); x[5] = bfhi(w.z); x[6] = bflo(w.w); x[7] = bfhi(w.w); }
__device__ __forceinline__ void ld8f(const float* p, float (&x)[8]) { const f32x4 a = *(const f32x4*)p, b = *(const f32x4*)(p + 4); x[0] = a.x; x[1] = a.y; x[2] = a.z; x[3] = a.w; x[4] = b.x; x[5] = b.y; x[6] = b.z; x[7] = b.w; }
__device__ __forceinline__ void conv_block(ArgP a, int layer, int r0, int lane, const bf16* U, bf16* BG) {
    int kind = 0; size_t r1 = 0, r2 = 0; const float* c1 = nullptr; const float* c2 = nullptr; float* st_out = nullptr;
    if (r0 < R_META) { const int b = r0 >> 11, s = r0 & (SEQ - 1);
        if (s >= 4) { r1 = r0 - 1; r2 = r0 - 2; } else { r1 = R_META + b * NMETA + 15; r2 = R_META + b * NMETA + 14; }
        if (s == SEQ - 4) st_out = a->out + O_SCP + (size_t)(layer * NB + b) * 2 * DM;
    } else if (r0 < R_SAMP) { const int j = (r0 - R_META) & 15;
        if (j >= 4) { r1 = r0 - 1; r2 = r0 - 2; } else kind = 1;
    } else { const int db = (r0 - R_SAMP) >> 3, i = (r0 - R_SAMP) & 7; const float* cp = a->in[I_SCONV] + (size_t)(layer * DBATCH + db) * 2 * DM;
        if (i >= 4) { r1 = r0 - 1; r2 = r0 - 2; } else { kind = 2; c1 = cp + DM; c2 = cp; }
        if (i == DSEQ - 4) st_out = a->out + O_SCS + (size_t)(layer * DBATCH + db) * 2 * DM;
    }
    const float* cw = a->in[I_CONVW] + (size_t)layer * 3 * DM;
#pragma unroll 1
    for (int q = 0; q < 2; ++q) {
        const int col = lane * 8 + 512 * q;
        u32x4 uw[4], bw[4], p1w = {0u, 0u, 0u, 0u}, p2w = {0u, 0u, 0u, 0u};
#pragma unroll
        for (int k = 0; k < 4; ++k) { uw[k] = *(const u32x4*)(U + (size_t)(r0 + k) * DM + col); bw[k] = *(const u32x4*)(BG + (size_t)(r0 + k) * DM + col); }
        float p1[8], p2[8], w0[8], w1[8], w2[8];
        if (kind == 0) { p1w = *(const u32x4*)(U + r1 * DM + col); p2w = *(const u32x4*)(U + r2 * DM + col); }
        else if (kind == 2) { ld8f(c1 + col, p1); ld8f(c2 + col, p2); }
        ld8f(cw + col, w0); ld8f(cw + DM + col, w1); ld8f(cw + 2 * DM + col, w2);
        if (kind != 2) { const u32x4 a1 = p1w, a2 = p2w;
            p1[0] = bflo(a1.x); p1[1] = bfhi(a1.x); p1[2] = bflo(a1.y); p1[3] = bfhi(a1.y); p1[4] = bflo(a1.z); p1[5] = bfhi(a1.z); p1[6] = bflo(a1.w); p1[7] = bfhi(a1.w);
            p2[0] = bflo(a2.x); p2[1] = bfhi(a2.x); p2[2] = bflo(a2.y); p2[3] = bfhi(a2.y); p2[4] = bflo(a2.z); p2[5] = bfhi(a2.z); p2[6] = bflo(a2.w); p2[7] = bfhi(a2.w); }
#pragma unroll
        for (int k = 0; k < 4; ++k) {
            float u0[8], bg[8], y[8];
            { const u32x4 w = uw[k]; u0[0] = bflo(w.x); u0[1] = bfhi(w.x); u0[2] = bflo(w.y); u0[3] = bfhi(w.y); u0[4] = bflo(w.z); u0[5] = bfhi(w.z); u0[6] = bflo(w.w); u0[7] = bfhi(w.w); }
            { const u32x4 w = bw[k]; bg[0] = bflo(w.x); bg[1] = bfhi(w.x); bg[2] = bflo(w.y); bg[3] = bfhi(w.y); bg[4] = bflo(w.z); bg[5] = bfhi(w.z); bg[6] = bflo(w.w); bg[7] = bfhi(w.w); }
#pragma unroll
            for (int x = 0; x < 8; ++x) y[x] = bg[x] * (w0[x] * p2[x] + w1[x] * p1[x] + w2[x] * u0[x]);
            u32x4 wv; wv.x = cvt_pk_bf16(y[0], y[1]); wv.y = cvt_pk_bf16(y[2], y[3]); wv.z = cvt_pk_bf16(y[4], y[5]); wv.w = cvt_pk_bf16(y[6], y[7]);
            *(u32x4*)(BG + (size_t)(r0 + k) * DM + col) = wv;
            if (st_out && k >= 2) { float* so = st_out + (size_t)(k - 2) * DM + col; *(f32x4*)so = (f32x4){u0[0], u0[1], u0[2], u0[3]}; *(f32x4*)(so + 4) = (f32x4){u0[4], u0[5], u0[6], u0[7]}; }
#pragma unroll
            for (int x = 0; x < 8; ++x) { p2[x] = p1[x]; p1[x] = u0[x]; }
        }
    }
}

__device__ __forceinline__ void mixer_phase(ArgP a, LAS unsigned char* lds, int layer, int G) {
    unsigned char* ws = a->ws;
    bf16* P = (bf16*)(ws + WS_P); const size_t BS = ROWBUF / 2;
    bf16* Qb = P; const bf16* Kb = P + BS; const bf16* Vb = P + 2 * BS; const bf16* Gb = P + 3 * BS; bf16* BGb = P + 4 * BS; const bf16* Ub = P + 5 * BS;
    const f32x2* tab = (const f32x2*)(ws + WS_TAB);
    const int wgi = blockIdx.x;
    for (int ci = wgi; ci < NB * NH; ci += G) {
        const int b = ci >> 3, h = ci & 7;
#ifdef PROBE_CHAIN
        ret_chain<false>(lds, b, h, Qb, Kb, Vb, Gb, tab, a->out + O_SRP + ((size_t)(layer * NB + b) * NH + h) * HD * HD);
#endif
        ret_chain<true>(lds, b, h, Qb, Kb, Vb, Gb, tab, a->out + O_SRP + ((size_t)(layer * NB + b) * NH + h) * HD * HD);
    }
    const int first_other = (G > NB * NH) ? NB * NH : 0, n_other = G - first_other;
    if (wgi >= first_other) {
        const int oi = wgi - first_other;
        int tid_ = threadIdx.x; asm volatile("" : "+v"(tid_));
        const int lane = tid_ & 63, wave = tid_ >> 6;
        unsigned* cnt = (unsigned*)(ws + WS_CTL) + 3584 + 64 * layer;
        for (int blk = oi * NWAVES + wave; blk < M_REAL / 4; blk += n_other * NWAVES) conv_block(a, layer, blk * 4, lane, Ub, BGb);
        asm volatile("s_waitcnt vmcnt(0)" ::: "memory"); __syncthreads();
        if (tid_ == 0) { __builtin_amdgcn_fence(__ATOMIC_RELEASE, "agent"); asm volatile("s_waitcnt vmcnt(0)" ::: "memory"); (void)__hip_atomic_fetch_add(cnt, 1u, __ATOMIC_RELAXED, __HIP_MEMORY_SCOPE_AGENT); }
        for (int it = oi; it < DBATCH * NH; it += n_other) {
            const int db = it >> 3, h = it & 7; const size_t so = ((size_t)(layer * DBATCH + db) * NH + h) * HD * HD;
#ifdef PROBE_OTHERS
            ret_sample_item<false>(lds, db, h, Qb, Kb, Vb, Gb, tab, a->in[I_SRET] + so, a->out + O_SRS + so);
#endif
            ret_sample_item<true>(lds, db, h, Qb, Kb, Vb, Gb, tab, a->in[I_SRET] + so, a->out + O_SRS + so);
        }
        if (tid_ == 0) { unsigned sp = 0; while (__hip_atomic_load(cnt, __ATOMIC_RELAXED, __HIP_MEMORY_SCOPE_AGENT) < (unsigned)n_other) { __builtin_amdgcn_s_sleep(2); if (++sp > (1u << 22)) break; }
            __builtin_amdgcn_fence(__ATOMIC_ACQUIRE, "agent"); asm volatile("s_waitcnt vmcnt(0)" ::: "memory"); }
        __syncthreads();
        {
            pg8::Gemm g{BGb  , (const bf16*)(ws + WS_W + (size_t)layer * W_LAYER + W_CONV), MP, DM, DM}; pg8::EpiGate<false> E{P + 5 * BS  , P + 7 * BS  };
            { pg8::OneOf S; S.init(MP, DM, DM, oi < CO_LO ? oi : oi + (CO_HI - CO_LO));
                pg8::gemm_phase<pg8::EpiGate<false>, pg8::OneOf, true, true>(lds, g, S, E); }
        }
        { __syncthreads();
            if (layer > 0) convert_weights(a, (LAS float*)(lds + wave * 16384), lane, layer * IT_LAYER + IT_IN, IT_SQ, oi * NWAVES + wave, n_other * NWAVES);
            convert_weights(a, (LAS float*)(lds + wave * 16384), lane, layer * IT_LAYER + IT_IN + 2 * IT_SQ, IT_LAYER - IT_IN - 2 * IT_SQ, oi * NWAVES + wave, n_other * NWAVES); }
        if (layer + 1 < DEPTH) { __syncthreads(); convert_weights(a, (LAS float*)(lds + wave * 16384), lane, (layer + 1) * IT_LAYER, IT_IN, oi * NWAVES + wave, n_other * NWAVES); }
    }
}

#define XB_TMO      128
#define XB_XCNT(j)  (256  + 64 * (j))
#define XB_XSUB(j)  (1280 + 64 * (j))
#define XB_XGEN(j)  (2304 + 64 * (j))
#define XB_TOP      3328
#define XB_TOPGEN   3392
#define XCD_BAR_WORDS 3456
#define XB_SPIN_CAP (1u << 18)

__device__ __forceinline__ unsigned xb_ld(unsigned* p)              { return __hip_atomic_load(p, __ATOMIC_RELAXED, __HIP_MEMORY_SCOPE_AGENT); }
__device__ __forceinline__ unsigned xb_add(unsigned* p, unsigned v) { return __hip_atomic_fetch_add(p, v, __ATOMIC_RELAXED, __HIP_MEMORY_SCOPE_AGENT); }
__device__ __forceinline__ unsigned xb_xcc_id() { return (unsigned)__builtin_amdgcn_s_getreg((3 << 11) | 20) & 0xFu; }
#define XB_SPIN(cond, bar) do { unsigned _sp = 0; while (cond) { __builtin_amdgcn_s_sleep(1); \
    if ((++_sp & 255u) == 0u) { if (xb_ld(&(bar)[XB_TMO])) break; if (_sp > XB_SPIN_CAP) { atomicAdd(&(bar)[XB_TMO], 1u); break; } } } } while (0)

struct XcdBarrier {
    unsigned* bar; unsigned x;
    volatile LAS unsigned* st;
};

__device__ __forceinline__ XcdBarrier xcd_barrier_post(unsigned* bar, volatile LAS unsigned* st) {
    XcdBarrier b; b.bar = bar; b.x = xb_xcc_id(); b.st = st;
    if (threadIdx.x == 0) (void)xb_add(&bar[XB_XCNT(b.x)], 1u);
    return b;
}
__device__ __forceinline__ void xcd_barrier_complete(unsigned* bar, unsigned x, unsigned& nloc, unsigned& nx) {
    const unsigned G = gridDim.x * gridDim.y * gridDim.z;
    unsigned sum, cnt, mine, sp = 0u;
    for (;;) {
        sum = 0u; cnt = 0u; mine = 0u;
#pragma unroll
        for (unsigned j = 0; j < 16; ++j) { const unsigned c = xb_ld(&bar[XB_XCNT(j)]); sum += c; cnt += (c > 0u) ? 1u : 0u; mine = (j == x) ? c : mine; }
        if (sum == G) break;
        __builtin_amdgcn_s_sleep(1);
        if ((++sp & 255u) == 0u) { if (xb_ld(&bar[XB_TMO])) break; if (sp > XB_SPIN_CAP) { atomicAdd(&bar[XB_TMO], 1u); break; } }
    }
    nloc = mine > 0u ? mine : 1u; nx = cnt > 0u ? cnt : 1u;
}

__device__ __forceinline__ void xcd_barrier(const XcdBarrier& b) {
    asm volatile("s_waitcnt vmcnt(0)" ::: "memory");
    __syncthreads();
    if (threadIdx.x == 0) {
        unsigned* bar = b.bar;
        __builtin_amdgcn_s_waitcnt(0);
        unsigned nloc = b.st[0], nx = b.st[1];
        if (nloc == 0u) { xcd_barrier_complete(bar, b.x, nloc, nx); b.st[0] = nloc; b.st[1] = nx; }
        const unsigned old = xb_add(&bar[XB_XSUB(b.x)], 1u);
        const unsigned gen = old / nloc;
        if (old + 1u == (gen + 1u) * nloc) {
            __builtin_amdgcn_fence(__ATOMIC_RELEASE, "agent");
            asm volatile("s_waitcnt vmcnt(0)" ::: "memory");
            const unsigned og = xb_add(&bar[XB_TOP], 1u);
            const unsigned tg = og / nx;
            if (og + 1u == (tg + 1u) * nx) xb_add(&bar[XB_TOPGEN], 1u);
            else XB_SPIN(xb_ld(&bar[XB_TOPGEN]) == tg, bar);
            __builtin_amdgcn_fence(__ATOMIC_ACQUIRE, "agent");
            xb_add(&bar[XB_XGEN(b.x)], 1u);
            asm volatile("s_waitcnt vmcnt(0)" ::: "memory");
        } else {
            XB_SPIN(xb_ld(&bar[XB_XGEN(b.x)]) == gen, bar);
            __builtin_amdgcn_fence(__ATOMIC_ACQUIRE, "agent");
            asm volatile("s_waitcnt vmcnt(0)" ::: "memory");
        }
    }
    __syncthreads();
}

constexpr int N_PHASES = 1 + 8 * DEPTH;
__global__ void __launch_bounds__(NTHREADS, 2) fwd_megakernel(Args a_) {
    ArgP a = argp();
    extern __shared__ __attribute__((aligned(16))) unsigned char lds_raw[];
    LAS unsigned char* lds = (LAS unsigned char*)lds_raw;
    cg::grid_group grid = cg::this_grid();
    const int G = gridDim.x;
    unsigned char* ws = a->ws;
    bf16* XN = (bf16*)(ws + WS_XN); bf16* H = (bf16*)(ws + WS_H);
    bf16* P = (bf16*)(ws + WS_P); const size_t BS = ROWBUF / 2;
    bf16* MG = P + 5 * BS  ; bf16* ACT = P + BS;
#define IN(k) true
#ifdef ONLY
#define PHON(x) ((x) == ONLY)
#else
#define PHON(x) true
#endif
#ifdef PROBE_SYNC
#define SEAM(k) do { if (IN(k) && IN((k) + 1)) { xcd_barrier(xbar); xcd_barrier(xbar); } } while (0)
#else
#define SEAM(k) do { if (IN(k) && IN((k) + 1)) { XcdBarrier b_ = xbar; asm volatile("" : "+s"(b_.bar), "+s"(b_.x)); xcd_barrier(b_); } } while (0)
#endif
    unsigned* ctl = (unsigned*)(ws + WS_CTL);
    if (blockIdx.x == 0) for (int i = threadIdx.x; i < 4096; i += NTHREADS) __hip_atomic_store(ctl + i, 0u, __ATOMIC_RELAXED, __HIP_MEMORY_SCOPE_AGENT);
    volatile LAS unsigned* xst = (volatile LAS unsigned*)(lds + LDS_BYTES - 64);
    if (threadIdx.x < 2) xst[threadIdx.x] = 0u;
    __syncthreads();
#ifdef PROBE_P0
    if (IN(0)) { p0_prologue(argp(), lds, G); __syncthreads(); }
#endif
    if (IN(0)) { p0_prologue(argp(), lds, G); __syncthreads(); }
    grid.sync();
    XcdBarrier xbar = xcd_barrier_post(ctl, xst);
#pragma unroll 1
    for (int l = 0; l < DEPTH; ++l) {
        const int pb = 1 + 8 * l;
        const unsigned char* wl = ws + WS_W + (size_t)l * W_LAYER;
        if (PHON(0) && IN(pb + 0)) {
            pg8::Gemm g{XN, (const bf16*)(wl + W_IN), MP, NIN, DM}; pg8::StaticOrder S; S.init(MP, NIN, G, bxl(), DM);
            pg8::EpiProj E{P, BS, (const float*)(ws + WS_TAB)};
            pg8::gemm_phase<pg8::EpiProj, pg8::StaticOrder, true, true>(lds, g, S, E);
#ifdef PROBE_G16
            pg8::gemm_phase<pg8::EpiProj, pg8::StaticOrder, true, true>(lds, g, S, E);
#endif
        }
        SEAM(pb + 0);
        #ifndef NO_MIXER
        if (PHON(1) && IN(pb + 1)) mixer_phase(argp(), lds, l, G);
#endif
        SEAM(pb + 1);
        if (PHON(2) && IN(pb + 2)) {
            { const int bx = bxl(); pg8::OneOf S0; S0.init(MP, DM, DM, (bx >= CO_LO && bx < CO_HI) ? bx : -1);
                pg8::Gemm g{P + 4 * BS  , (const bf16*)(wl + W_CONV), MP, DM, DM}; pg8::EpiGate<false> E{MG, P + 7 * BS};
                pg8::gemm_phase<pg8::EpiGate<false>, pg8::OneOf, true, true>(lds, g, S0, E); }
            pg8::StaticOrder S; S.init(MP, DM, G, bxl(), DM);
            { pg8::Gemm g{P  , (const bf16*)(wl + W_RET), MP, DM, DM}; pg8::EpiGate<true> E{MG, P + 6 * BS};
              pg8::gemm_phase<pg8::EpiGate<true>, pg8::StaticOrder, true, true>(lds, g, S, E); }
            {
                const int nbusy = (MP / 256) * (DM / 256) - G, first = CO_HI, bx = bxl();
                if (bx >= first) { int tid_ = threadIdx.x; asm volatile("" : "+v"(tid_)); const int lane = tid_ & 63, wave = tid_ >> 6;
                    LAS float* scr = (LAS float*)(lds + wave * 16384); const int fw = (bx - first) * NWAVES + wave, nfw = (G - first) * NWAVES;
                    if (l + 1 < DEPTH) convert_weights(argp(), scr, lane, (l + 1) * IT_LAYER + IT_IN + IT_SQ, IT_SQ, fw, nfw); }
            }
        }
        SEAM(pb + 2);
        if (PHON(3) && IN(pb + 3)) {
            pg8::Gemm g{MG, (const bf16*)(wl + W_O), MP, DM, DM}; pg8::SplitOrder<4, DM / 256> S; S.init(R_META, MP, DM, DM, G, bxl());
            pg8::EpiResid E{l == 0 ? argp()->in[I_XP] : (const float*)nullptr, H, (bf16*)(ws + WS_P + 6 * ROWBUF), DM / 64, R_META, MP - R_META};
            pg8::gemm_phase<pg8::EpiResid, pg8::SplitOrder<4, DM / 256>, true, true>(lds, g, S, E);
        }
        SEAM(pb + 3);
        if (PHON(4) && IN(pb + 4)) rms_phase<4>(argp(), argp()->in[I_NFG] + (size_t)l * DM, false, G);
        SEAM(pb + 4);
        if (PHON(5) && IN(pb + 5)) {
            pg8::Gemm g{XN, (const bf16*)(wl + W_GU), MP, 2 * DFF, DM}; pg8::StaticOrder S; S.init(MP, 2 * DFF, G, bxl(), DM);
            pg8::EpiGateUp E{ACT, DFF};
            pg8::gemm_phase<pg8::EpiGateUp, pg8::StaticOrder, true, true>(lds, g, S, E);
#ifdef PROBE_G16
            pg8::gemm_phase<pg8::EpiGateUp, pg8::StaticOrder, true, true>(lds, g, S, E);
#endif
        }
        SEAM(pb + 5);
        if (PHON(6) && IN(pb + 6)) {
            pg8::Gemm g{ACT, (const bf16*)(wl + W_DN), MP, DM, DFF}; pg8::SplitOrder<11, DM / 256> S; S.init(R_META, MP, DM, DFF, G, bxl());
            pg8::EpiResid E{nullptr, H, (bf16*)(ws + WS_P + 6 * ROWBUF), DFF / 64, R_META, MP - R_META};
            pg8::gemm_phase<pg8::EpiResid, pg8::SplitOrder<11, DM / 256>, true, true>(lds, g, S, E);
        }
        SEAM(pb + 6);
        if (PHON(7) && IN(pb + 7)) { if (l + 1 < DEPTH) rms_phase<11>(argp(), argp()->in[I_NMG] + (size_t)(l + 1) * DM, false, G); else rms_phase<11>(argp(), argp()->in[I_FNG], true, G); }
        if (l + 1 < DEPTH) SEAM(pb + 7);
    }
#undef IN
#undef SEAM
}

extern "C" void kernel_launch(void* const* d_in, const int* in_sizes, int n_in, void* d_out, int out_size, void* d_ws, size_t ws_size, hipStream_t stream) {
    static int grid = 0;
    if (grid == 0) {
        if (n_in != 15 || (size_t)out_size != O_END || ws_size < WS_END) { fprintf(stderr, "kernel_launch: unexpected shapes: n_in %d out %d ws %zu (need %zu)\n", n_in, out_size, ws_size, (size_t)WS_END); grid = -1; return; }
        int dev = 0, cus = 0, per_cu = 0;
        hipGetDevice(&dev);
        hipDeviceGetAttribute(&cus, hipDeviceAttributeMultiprocessorCount, dev);
        if (hipFuncSetAttribute((const void*)fwd_megakernel, hipFuncAttributeMaxDynamicSharedMemorySize, LDS_BYTES) != hipSuccess) { fprintf(stderr, "kernel_launch: hipFuncSetAttribute failed\n"); grid = -1; return; }
        if (hipOccupancyMaxActiveBlocksPerMultiprocessor(&per_cu, (const void*)fwd_megakernel, NTHREADS, LDS_BYTES) != hipSuccess || per_cu < 1) { fprintf(stderr, "kernel_launch: occupancy query failed (%d)\n", per_cu); (void)hipGetLastError(); per_cu = 1; }
        if (per_cu > 1) per_cu = 1;
        grid = cus * per_cu;
        if (grid != 256) { fprintf(stderr, "kernel_launch: this build deals its mixer-phase GEMM units for exactly 256 workgroups (got %d); nothing launched\n", grid); grid = -1; return; }
    }
    if (grid < 0) return;
    Args a{};
    for (int i = 0; i < 15; ++i) a.in[i] = (const float*)d_in[i];
    a.out = (float*)d_out; a.ws = (unsigned char*)d_ws; a.ph_lo = 0; a.ph_hi = N_PHASES;
    void* args[] = {&a};
    hipError_t e = hipLaunchCooperativeKernel((const void*)fwd_megakernel, dim3(grid), dim3(NTHREADS), args, LDS_BYTES, stream);
    if (e != hipSuccess) fprintf(stderr, "cooperative launch failed: %s (grid %d)\n", hipGetErrorString(e), grid);
}
```

```cpp
#include <hip/hip_runtime.h>
#include <hip/hip_cooperative_groups.h>
#include <cstdio>
#include <cstdint>
namespace cg = cooperative_groups;

namespace pg8 {
#define PG8_LAS __attribute__((address_space(3)))
typedef unsigned short bf16_t;
typedef short bf16x8 __attribute__((ext_vector_type(8)));
typedef float f32x4 __attribute__((ext_vector_type(4)));
typedef unsigned u32x4 __attribute__((ext_vector_type(4)));
constexpr int BM = 256, BK = 64, HALF = 128, HTB = HALF * BK * 2  , STAGE_BYTES = 8 * HTB, NXCD = 8, WGM = 8;

__host__ __device__ __forceinline__ int lds_byte(int r, int c) { const int st = (r >> 4) * 2 + (c >> 5), rr = r & 15, cc = c & 31, ob = rr * 64 + cc * 2; return st * 1024 + (ob ^ (((ob >> 9) & 1) << 5)); }
__host__ __device__ __forceinline__ void stage_rc(int b, int& R, int& C) { const int st = b / 1024, sb = b % 1024, swz = sb ^ (((sb >> 9) & 1) << 5); R = (st >> 1) * 16 + swz / 64; C = (st & 1) * 32 + (swz % 64) / 2; }
__host__ __device__ __forceinline__ int perm32(int rho) { const int n = rho >> 4, i = rho & 15; return 8 * (i >> 2) + 4 * n + (i & 3); }

struct Unit { int pm, pn, kt0, nkt; };
struct Gemm { const bf16_t* A; const bf16_t* Bt; int M, N, K; };

struct StaticOrder {
    int nM, nN, nwg, G, c;
    int nktf;
    __host__ __device__ void init(int M, int N, int G_, int c_, int K) { nM = M / BM; nN = N / BM; nwg = nM * nN; G = G_; c = c_; nktf = K / BK; }
    __host__ __device__ bool next(int i, Unit& u) const { return map((long)i * G + c, u); }
    __host__ __device__ bool map(long L, Unit& u) const {
        const bool ok = L < nwg; if (!ok) L = 0;
        u.kt0 = 0; u.nkt = nktf;
        int wgid = (int)L; { const int q = nwg / NXCD, r = nwg % NXCD, xcd = wgid % NXCD, off = wgid / NXCD; wgid = (xcd < r ? xcd * (q + 1) : r * (q + 1) + (xcd - r) * q) + off; }
        const int nig = WGM * nN, gid = wgid / nig, fm = gid * WGM, gsz = (nM - fm) < WGM ? (nM - fm) : WGM;
        u.pm = fm + ((wgid % nig) % gsz); u.pn = (wgid % nig) / gsz; return ok;
    }
    __device__ __forceinline__ void a_ready(const Unit&) const {}
    __device__ __forceinline__ void done(const Unit&) const {}
};

struct OneOf {
    StaticOrder base; long L;
    __host__ __device__ void init(int M, int N, int K, long L_) { base.init(M, N, 1, 0, K); L = L_; }
    __host__ __device__ bool next(int i, Unit& u) const { const bool ok = base.map(L < 0 ? 0 : L, u); return ok && i == 0 && L >= 0; }
    __device__ __forceinline__ void a_ready(const Unit&) const {}
    __device__ __forceinline__ void done(const Unit&) const {}
};

template <int S, int NN> struct SplitOrder {
    StaticOrder base; int nrest, nkp, G, c;
    __host__ __device__ void init(int M0, int Mtot, int N, int K, int G_, int c_) { base.init(M0, N, G_, c_, K); nrest = ((Mtot - M0) / BM) * NN * S; nkp = (K / BK) / S; G = G_; c = c_; }
    __host__ __device__ bool next(int i, Unit& u) const {
        const long L = (long)i * G + c; const bool full = L < base.nwg;
        Unit a; (void)base.map(full ? L : 0, a);
        const unsigned p = full ? 0u : (unsigned)(L - base.nwg);
        const unsigned t = p / (unsigned)S, s = p - t * (unsigned)S;
        u.pm = full ? a.pm : base.nM + (int)(t / (unsigned)NN); u.pn = full ? a.pn : (int)(t % (unsigned)NN);
        u.kt0 = full ? 0 : (int)s * nkp; u.nkt = full ? base.nktf : nkp;
        return full || p < (unsigned)nrest;
    }
    __device__ __forceinline__ void a_ready(const Unit&) const {}
    __device__ __forceinline__ void done(const Unit&) const {}
};

__device__ __forceinline__ unsigned cvt_pk_bf16(float lo, float hi) { unsigned r; asm volatile("v_cvt_pk_bf16_f32 %0, %1, %2" : "=v"(r) : "v"(lo), "v"(hi)); return r; }
typedef float f32x2 __attribute__((ext_vector_type(2)));

typedef unsigned u32x2 __attribute__((ext_vector_type(2)));
__device__ __forceinline__ float bflo(unsigned w) { return __builtin_bit_cast(float, w << 16); }
__device__ __forceinline__ float bfhi(unsigned w) { return __builtin_bit_cast(float, w & 0xffff0000u); }
__device__ __forceinline__ float sigm(float x) { return __builtin_amdgcn_rcpf(1.f + __expf(-x)); }
__device__ __forceinline__ float silu(float x) { return x * __builtin_amdgcn_rcpf(1.f + __expf(-x)); }
__device__ __forceinline__ u32x4 pack8(const f32x4 a, const f32x4 b) { u32x4 w; w.x = cvt_pk_bf16(a[0], a[1]); w.y = cvt_pk_bf16(a[2], a[3]); w.z = cvt_pk_bf16(b[0], b[1]); w.w = cvt_pk_bf16(b[2], b[3]); return w; }

struct EpiProj {
    static constexpr bool PERM = true, AFTER_DRAIN = false;
    bf16_t* P; size_t bstride; const float* tab;
    __device__ __forceinline__ void operator()(const f32x4 (&acc)[2][2][4][2], const Unit& u, int wr, int wc, int fr, int fq) const {
        const int pn = u.pn; const int row0 = u.pm * BM + wr * 64 + fr;
        if (pn < 8) {
            const int X = 2 * (pn & 3) + (wc >> 1), dl = (wc & 1) * 32 + 8 * fq;
            const float ksc = pn >= 4 ? 0.08838834764831845f : 1.f;
            bf16_t* base = P + (size_t)(pn >> 2) * bstride + X * 128 + dl;
#pragma unroll
            for (int ai = 0; ai < 2; ++ai)
#pragma unroll
                for (int m = 0; m < 4; ++m) { const int row = row0 + ai * HALF + m * 16;
                    const int pidx = row < 16384 ? 16 + (row & 2047) : row < 16512 ? ((row - 16384) & 15) : row < 17536 ? 2064 + ((row - 16512) & 7) : 0;
                    const f32x4* tp = (const f32x4*)(tab + ((size_t)pidx * 64 + dl) * 2);
                    const f32x4 t0 = tp[0], t1 = tp[1], t2 = tp[2], t3 = tp[3];
                    const f32x4 c0 = {t0.x, t0.z, t1.x, t1.z}, s0 = {t0.y, t0.w, t1.y, t1.w}, c1 = {t2.x, t2.z, t3.x, t3.z}, s1 = {t2.y, t2.w, t3.y, t3.w};
                    const f32x4 a0 = acc[ai][0][m][0], a1 = acc[ai][0][m][1], b0 = acc[ai][1][m][0], b1 = acc[ai][1][m][1];
                    const f32x4 o10 = (a0 * c0 - b0 * s0) * ksc, o11 = (a1 * c1 - b1 * s1) * ksc, o20 = (a0 * s0 + b0 * c0) * ksc, o21 = (a1 * s1 + b1 * c1) * ksc;
                    bf16_t* rowp = base + (size_t)row * 1024;
                    *(u32x4*)rowp = pack8(o10, o11); *(u32x4*)(rowp + 64) = pack8(o20, o21);
                    asm volatile("" ::: "memory"); }
        } else if (pn >= 20 && pn < 28) {
            bf16_t* base = P + 5 * bstride + (pn - 20) * 128 + wc * 32 + 8 * fq;
#pragma unroll
            for (int ai = 0; ai < 2; ++ai)
#pragma unroll
                for (int m = 0; m < 4; ++m) { bf16_t* rowp = base + (size_t)(row0 + ai * HALF + m * 16) * 1024;
                    const f32x4 v0 = acc[ai][0][m][0] * acc[ai][1][m][0], v1 = acc[ai][0][m][1] * acc[ai][1][m][1];
                    *(u32x4*)rowp = pack8(v0, v1); }
        } else {
            int buf, colt, act;
            if (pn < 20) { buf = pn >> 2; colt = (pn & 3) * 256; act = (buf == 3) ? 1 : 0; }
            else { buf = 6 + ((pn - 28) >> 2); colt = ((pn - 28) & 3) * 256; act = 2; }
            bf16_t* base = P + (size_t)buf * bstride + colt + wc * 32 + 8 * fq;
#pragma unroll
            for (int ai = 0; ai < 2; ++ai)
#pragma unroll
                for (int m = 0; m < 4; ++m) { bf16_t* rowp = base + (size_t)(row0 + ai * HALF + m * 16) * 1024;
#pragma unroll
                    for (int bj = 0; bj < 2; ++bj) { f32x4 v0 = acc[ai][bj][m][0], v1 = acc[ai][bj][m][1];
                        if (act == 1) {
#pragma unroll
                            for (int j = 0; j < 4; ++j) { v0[j] = silu(v0[j]); v1[j] = silu(v1[j]); } }
                        else if (act == 2) {
#pragma unroll
                            for (int j = 0; j < 4; ++j) { v0[j] = sigm(v0[j]); v1[j] = sigm(v1[j]); } }
                        *(u32x4*)(rowp + bj * HALF) = pack8(v0, v1); } }
        }
    }
};

struct EpiGateUp {
    static constexpr bool PERM = true, AFTER_DRAIN = false;
    bf16_t* O; int ldc;
    __device__ __forceinline__ void operator()(const f32x4 (&acc)[2][2][4][2], const Unit& u, int wr, int wc, int fr, int fq) const {
        const int row0 = u.pm * BM + wr * 64 + fr; bf16_t* base = O + u.pn * 128 + wc * 32 + 8 * fq;
#pragma unroll
        for (int ai = 0; ai < 2; ++ai)
#pragma unroll
            for (int m = 0; m < 4; ++m) { bf16_t* rowp = base + (size_t)(row0 + ai * HALF + m * 16) * ldc; f32x4 v0, v1;
#pragma unroll
                for (int j = 0; j < 4; ++j) { v0[j] = silu(acc[ai][0][m][0][j]) * acc[ai][1][m][0][j]; v1[j] = silu(acc[ai][0][m][1][j]) * acc[ai][1][m][1][j]; }
                *(u32x4*)rowp = pack8(v0, v1); }
    }
};

template <bool ADD> struct EpiGate {
    static constexpr bool PERM = true, AFTER_DRAIN = false;
    bf16_t* MG; const bf16_t* Gt;
    __device__ __forceinline__ void operator()(const f32x4 (&acc)[2][2][4][2], const Unit& u, int wr, int wc, int fr, int fq) const {
        const int row0 = u.pm * BM + wr * 64 + fr; const size_t col0 = (size_t)u.pn * BM + wc * 32 + 8 * fq;
#pragma unroll
        for (int ai = 0; ai < 2; ++ai)
#pragma unroll
            for (int m = 0; m < 4; ++m) { const size_t off = (size_t)(row0 + ai * HALF + m * 16) * 1024 + col0;
#pragma unroll
                for (int bj = 0; bj < 2; ++bj) { const u32x4 gw = *(const u32x4*)(Gt + off + bj * HALF);
                    f32x4 v0 = acc[ai][bj][m][0], v1 = acc[ai][bj][m][1];
                    v0[0] *= bflo(gw.x); v0[1] *= bfhi(gw.x); v0[2] *= bflo(gw.y); v0[3] *= bfhi(gw.y);
                    v1[0] *= bflo(gw.z); v1[1] *= bfhi(gw.z); v1[2] *= bflo(gw.w); v1[3] *= bfhi(gw.w);
                    if (ADD) { const u32x4 pw = *(const u32x4*)(MG + off + bj * HALF);
                        v0[0] += bflo(pw.x); v0[1] += bfhi(pw.x); v0[2] += bflo(pw.y); v0[3] += bfhi(pw.y);
                        v1[0] += bflo(pw.z); v1[1] += bfhi(pw.z); v1[2] += bflo(pw.w); v1[3] += bfhi(pw.w); }
                    *(u32x4*)(MG + off + bj * HALF) = pack8(v0, v1); }
                asm volatile("" ::: "memory"); }
    }
};

struct EpiResid {
    static constexpr bool PERM = true, AFTER_DRAIN = false;
    const float* X32; bf16_t* H; bf16_t* PART; int nkt_full, row0p, prows;
    __device__ __forceinline__ void operator()(const f32x4 (&acc)[2][2][4][2], const Unit& u, int wr, int wc, int fr, int fq) const {
        const int row0 = u.pm * BM + wr * 64 + fr; const int col0 = u.pn * BM + wc * 32 + 8 * fq;
        const bool part = u.nkt != nkt_full;
        bf16_t* pbase = PART + ((long)(u.kt0 / u.nkt) * prows - row0p) * 1024;
#pragma unroll
        for (int ai = 0; ai < 2; ++ai)
#pragma unroll
            for (int m = 0; m < 4; ++m) { const size_t ro = (size_t)(row0 + ai * HALF + m * 16) * 1024 + col0;
#pragma unroll
                for (int bj = 0; bj < 2; ++bj) { const size_t o = ro + bj * HALF;
                    if (part) *(u32x4*)(pbase + o) = pack8(acc[ai][bj][m][0], acc[ai][bj][m][1]);
                    else { f32x4 r0, r1;
                        if (X32) { r0 = *(const f32x4*)(X32 + o); r1 = *(const f32x4*)(X32 + o + 4); }
                        else { const u32x4 hw = *(const u32x4*)(H + o); r0 = (f32x4){bflo(hw.x), bfhi(hw.x), bflo(hw.y), bfhi(hw.y)}; r1 = (f32x4){bflo(hw.z), bfhi(hw.z), bflo(hw.w), bfhi(hw.w)}; }
                        *(u32x4*)(H + o) = pack8(r0 + acc[ai][bj][m][0], r1 + acc[ai][bj][m][1]); } }
                asm volatile("" ::: "memory"); }
    }
};

template <class Epi, class Sched, bool ALIGN_EPI = false, bool SP2 = false>
__device__ __forceinline__ void gemm_phase(PG8_LAS unsigned char* lds, const Gemm g, const Sched& S, const Epi& E) {
    int tid_ = threadIdx.x; asm volatile("" : "+v"(tid_));
    const int tid = tid_, wid = __builtin_amdgcn_readfirstlane(tid >> 6), lane = tid & 63, wr = wid >> 2, wc = wid & 3, fr = lane & 15, fq = lane >> 4;
    const int K = g.K;
    unsigned voffA[2], voffB[2];
#pragma unroll
    for (int i = 0; i < 2; ++i) { int R, C; stage_rc(tid * 16 + i * 8192, R, C); const int Rb = Epi::PERM ? ((R & ~31) + perm32(R & 31)) : R;
        voffA[i] = (unsigned)(R * K + C) * 2u; voffB[i] = (unsigned)(Rb * K + C) * 2u; }
    const size_t kstep = (size_t)(BK * 2);
    const size_t hstep = (size_t)HALF * K * 2;
    const size_t tstep = 2 * hstep;
    const unsigned ldsw = (unsigned)wid * 1024u;
    const int aoff = lds_byte(wr * 64 + fr, fq * 8), boff = lds_byte(wc * 32 + fr, fq * 8);
#define PG8_SA(b, h) (((b) * 2 + (h)) * HTB)
#define PG8_SB(b, h) ((4 + (b) * 2 + (h)) * HTB)
#define PG8_STAGE(bufoff, gbase, voff) do { _Pragma("unroll") for (int _i = 0; _i < 2; ++_i) \
        __builtin_amdgcn_global_load_lds((const unsigned*)((const char*)(gbase) + (voff)[_i]), (PG8_LAS unsigned*)(lds + (bufoff) + ldsw + _i * 8192), 16, 0, 0); } while (0)
#define PG8_LDA(dst, b, h) do { _Pragma("unroll") for (int m = 0; m < 4; ++m) _Pragma("unroll") for (int k = 0; k < 2; ++k) dst[m][k] = *(const PG8_LAS bf16x8*)(lds + PG8_SA(b, h) + aoff + m * 2048 + k * 1024); } while (0)
#define PG8_LDB(dst, b, h) do { _Pragma("unroll") for (int n = 0; n < 2; ++n) _Pragma("unroll") for (int k = 0; k < 2; ++k) dst[n][k] = *(const PG8_LAS bf16x8*)(lds + PG8_SB(b, h) + boff + n * 2048 + k * 1024); } while (0)
#define PG8_MMA(ai, bj, At, Bt) do { __builtin_amdgcn_s_setprio(1); _Pragma("unroll") for (int m = 0; m < 4; ++m) _Pragma("unroll") for (int n = 0; n < 2; ++n) _Pragma("unroll") for (int k = 0; k < 2; ++k) \
        acc[ai][bj][m][n] = __builtin_amdgcn_mfma_f32_16x16x32_bf16(Bt[n][k], At[m][k], acc[ai][bj][m][n], 0, 0, 0); __builtin_amdgcn_s_setprio(0); } while (0)
#define PG8_WAIT_V(n) asm volatile("s_waitcnt vmcnt(" #n ")" ::: "memory")
#define PG8_WAIT_L(n) asm volatile("s_waitcnt lgkmcnt(" #n ")" ::: "memory")
#define PG8_BAR __builtin_amdgcn_s_barrier()
#define PG8_SCHED __builtin_amdgcn_sched_barrier(0)
    Unit cur, nxt; int ui = 0;
    float zf_ = 0.f; asm volatile("" : "+v"(zf_));
    const f32x4 zero4_ = {zf_, zf_, zf_, zf_};
    if (!S.next(0, cur)) return;
    f32x4 acc[2][2][4][2];
#pragma unroll
    for (int a = 0; a < 2; ++a)
#pragma unroll
        for (int b = 0; b < 2; ++b)
#pragma unroll
            for (int m = 0; m < 4; ++m)
#pragma unroll
                for (int n = 0; n < 2; ++n) acc[a][b][m][n] = zero4_;
    bf16x8 At[4][2], B0[2][2], B1[2][2];
    const char* cA = (const char*)g.A + (size_t)cur.pm * tstep + (size_t)cur.kt0 * kstep; const char* cB = (const char*)g.Bt + (size_t)cur.pn * tstep + (size_t)cur.kt0 * kstep;
    S.a_ready(cur);
    if constexpr (SP2) {
        PG8_STAGE(PG8_SB(0, 0), cB, voffB); PG8_STAGE(PG8_SB(0, 1), cB + hstep, voffB); PG8_STAGE(PG8_SA(0, 0), cA, voffA); PG8_STAGE(PG8_SA(0, 1), cA + hstep, voffA);
        if (wr == 1) PG8_BAR;
        PG8_WAIT_V(2); PG8_BAR;
        PG8_STAGE(PG8_SB(1, 0), cB + kstep, voffB); PG8_STAGE(PG8_SA(1, 0), cA + kstep, voffA); PG8_STAGE(PG8_SB(1, 1), cB + hstep + kstep, voffB);
        PG8_WAIT_V(6); PG8_BAR;
    } else {
        PG8_STAGE(PG8_SB(0, 0), cB, voffB); PG8_STAGE(PG8_SA(0, 0), cA, voffA); PG8_STAGE(PG8_SB(0, 1), cB + hstep, voffB); PG8_STAGE(PG8_SA(0, 1), cA + hstep, voffA);
        if (wr == 1) PG8_BAR;
        PG8_WAIT_V(4); PG8_BAR;
        PG8_STAGE(PG8_SB(1, 0), cB + kstep, voffB); PG8_STAGE(PG8_SA(1, 0), cA + kstep, voffA); PG8_STAGE(PG8_SB(1, 1), cB + hstep + kstep, voffB);
        PG8_WAIT_V(6); PG8_BAR;
    }
    for (;;) {
        const bool has_next = S.next(ui + 1, nxt);
        const char* nA = has_next ? (const char*)g.A + (size_t)nxt.pm * tstep + (size_t)nxt.kt0 * kstep : cA; const char* nB = has_next ? (const char*)g.Bt + (size_t)nxt.pn * tstep + (size_t)nxt.kt0 * kstep : cB;
        const int nt = cur.nkt;
        for (int t = 0; t < nt; t += 2) {
            const bool last = (t == nt - 2);
            const char* a1 = cA + (size_t)(t + 1) * kstep;
            const char* a2 = last ? nA : cA + (size_t)(t + 2) * kstep; const char* b2 = last ? nB : cB + (size_t)(t + 2) * kstep;
            const char* a3 = a2 + kstep; const char* b3 = b2 + kstep;
            if (last && has_next) S.a_ready(nxt);
            if constexpr (SP2) {
            PG8_LDB(B0, 0, 0); PG8_LDB(B1, 0, 1); PG8_SCHED; PG8_LDA(At, 0, 0); PG8_STAGE(PG8_SA(1, 1), a1 + hstep, voffA);
            PG8_WAIT_V(8); PG8_WAIT_L(0); PG8_BAR; PG8_MMA(0, 0, At, B0); PG8_MMA(0, 1, At, B1); PG8_BAR; PG8_SCHED;
            PG8_LDA(At, 0, 1); PG8_STAGE(PG8_SB(0, 0), b2, voffB); PG8_STAGE(PG8_SB(0, 1), b2 + hstep, voffB); PG8_STAGE(PG8_SA(0, 0), a2, voffA);
            PG8_WAIT_V(8); PG8_WAIT_L(0); PG8_BAR; PG8_MMA(1, 0, At, B0); PG8_MMA(1, 1, At, B1); PG8_BAR; PG8_SCHED;
            PG8_LDB(B0, 1, 0); PG8_LDB(B1, 1, 1); PG8_SCHED; PG8_LDA(At, 1, 0); PG8_STAGE(PG8_SA(0, 1), a2 + hstep, voffA);
            PG8_WAIT_V(8); PG8_WAIT_L(0); PG8_BAR; PG8_MMA(0, 0, At, B0); PG8_MMA(0, 1, At, B1); PG8_BAR; PG8_SCHED;
            PG8_LDA(At, 1, 1); PG8_STAGE(PG8_SB(1, 0), b3, voffB); PG8_STAGE(PG8_SB(1, 1), b3 + hstep, voffB); PG8_STAGE(PG8_SA(1, 0), a3, voffA);
            PG8_WAIT_V(8); PG8_WAIT_L(0); PG8_BAR; PG8_MMA(1, 0, At, B0); PG8_MMA(1, 1, At, B1); PG8_BAR; PG8_SCHED;
            } else {
            PG8_LDB(B0, 0, 0); PG8_SCHED; PG8_LDA(At, 0, 0); PG8_STAGE(PG8_SA(1, 1), a1 + hstep, voffA);
            PG8_WAIT_L(8); PG8_BAR; PG8_WAIT_L(0); PG8_MMA(0, 0, At, B0); PG8_BAR; PG8_SCHED;
            PG8_LDB(B1, 0, 1); PG8_STAGE(PG8_SB(0, 0), b2, voffB);
            PG8_BAR; PG8_WAIT_L(0); PG8_MMA(0, 1, At, B1); PG8_BAR;
            PG8_LDA(At, 0, 1); PG8_STAGE(PG8_SA(0, 0), a2, voffA);
            PG8_BAR; PG8_WAIT_L(0); PG8_MMA(1, 0, At, B0); PG8_BAR; PG8_SCHED;
            PG8_STAGE(PG8_SB(0, 1), b2 + hstep, voffB);
            PG8_WAIT_V(6); PG8_BAR; PG8_MMA(1, 1, At, B1); PG8_BAR;
            PG8_LDB(B0, 1, 0); PG8_SCHED; PG8_LDA(At, 1, 0); PG8_STAGE(PG8_SA(0, 1), a2 + hstep, voffA);
            PG8_WAIT_L(8); PG8_BAR; PG8_WAIT_L(0); PG8_MMA(0, 0, At, B0); PG8_BAR; PG8_SCHED;
            PG8_LDB(B1, 1, 1); PG8_STAGE(PG8_SB(1, 0), b3, voffB);
            PG8_BAR; PG8_WAIT_L(0); PG8_MMA(0, 1, At, B1); PG8_BAR;
            PG8_LDA(At, 1, 1); PG8_STAGE(PG8_SA(1, 0), a3, voffA);
            PG8_BAR; PG8_WAIT_L(0); PG8_MMA(1, 0, At, B0); PG8_BAR; PG8_SCHED;
            PG8_STAGE(PG8_SB(1, 1), b3 + hstep, voffB);
            PG8_WAIT_V(6); PG8_BAR; PG8_MMA(1, 1, At, B1); PG8_BAR;
            }
        }
        if constexpr (ALIGN_EPI) { if (wr == 0) PG8_BAR; }
        if constexpr (!Epi::AFTER_DRAIN) { E(acc, cur, wr, wc, fr, fq); S.done(cur); }
        if (!has_next) break;
#pragma unroll
        for (int a = 0; a < 2; ++a)
#pragma unroll
            for (int b = 0; b < 2; ++b)
#pragma unroll
                for (int m = 0; m < 4; ++m)
#pragma unroll
                    for (int n = 0; n < 2; ++n) acc[a][b][m][n] = zero4_;
        cur = nxt; cA = nA; cB = nB; ++ui;
        if constexpr (ALIGN_EPI) { if (wr == 1) PG8_BAR; }
    }
    PG8_WAIT_V(0);
    if constexpr (!ALIGN_EPI) { if (wr == 0) PG8_BAR; }
    PG8_BAR;
    if constexpr (Epi::AFTER_DRAIN) { E.fused(acc, cur, wr, wc, fr, fq, lds, wid, lane); S.done(cur); }
#undef PG8_SA
#undef PG8_SB
#undef PG8_STAGE
#undef PG8_LDA
#undef PG8_LDB
#undef PG8_MMA
#undef PG8_WAIT_V
#undef PG8_WAIT_L
#undef PG8_BAR
#undef PG8_SCHED
}
}

#ifndef PG8_SP2
#define PG8_SP2 true
#endif

constexpr int DM = 1024, NB = 8, SEQ = 2048, NMETA = 16, DEPTH = 2, DBATCH = 128, DSEQ = 8, NH = 8, HD = 128, DFF = 2816, NIN = 9216;
constexpr int R_META = NB * SEQ;
constexpr int R_SAMP = R_META + NB * NMETA;
constexpr int M_REAL = R_SAMP + DBATCH * DSEQ;
constexpr int MP = 17664;
constexpr int NPOS = SEQ + NMETA + DSEQ;
constexpr float EPS = 1e-6f;
constexpr int NWAVES = 8, NTHREADS = 512;
constexpr int LDS_BYTES = 147456;
constexpr int CO_NU = (MP / 256) * (DM / 256), CO_LO = CO_NU - 256 > 0 ? CO_NU - 256 : 0, CO_HI = CO_LO + (CO_NU - (256 - NB * NH));
constexpr size_t O_YP = 0, O_YS = (size_t)NB * SEQ * DM, O_SRP = O_YS + (size_t)DBATCH * DSEQ * DM, O_SCP = O_SRP + (size_t)DEPTH * NB * NH * HD * HD,
                 O_SRS = O_SCP + (size_t)DEPTH * NB * 2 * DM, O_SCS = O_SRS + (size_t)DEPTH * DBATCH * NH * HD * HD, O_END = O_SCS + (size_t)DEPTH * DBATCH * 2 * DM;
constexpr size_t MiB = 1u << 20;
constexpr size_t WS_TAB = 0, WS_W = 2 * MiB;
constexpr size_t W_IN = 0, W_RET = (size_t)NIN * DM * 2, W_CONV = W_RET + (size_t)DM * DM * 2, W_O = W_CONV + (size_t)DM * DM * 2, W_GU = W_O + (size_t)DM * DM * 2,
                 W_DN = W_GU + (size_t)2 * DFF * DM * 2, W_LAYER = W_DN + (size_t)DFF * DM * 2;
constexpr size_t ROWBUF = (size_t)MP * DM * 2;
constexpr size_t WS_XN = WS_W + DEPTH * W_LAYER, WS_H = WS_XN + ROWBUF, WS_P = WS_H + 2 * ROWBUF, WS_END = WS_P + 8 * ROWBUF;
constexpr size_t WS_CTL = 3 * (MiB / 2);
static_assert((size_t)NPOS * 64 * 8 <= WS_CTL, "rope table fits");
static_assert((size_t)MP * DFF * 2 <= 3 * ROWBUF, "ACT overlays K|V|G");
static_assert((size_t)11 * (MP - R_META) * DM * 4 <= 2 * ROWBUF, "K-slice partial sums overlay GA|GB (dead after the gated out-projections)");

#define LAS __attribute__((address_space(3)))
typedef unsigned short bf16;
typedef pg8::f32x4 f32x4;
typedef pg8::u32x4 u32x4;
typedef pg8::u32x2 u32x2;
typedef pg8::bf16x8 bf16x8;
typedef float f32x2 __attribute__((ext_vector_type(2)));
using pg8::bflo; using pg8::bfhi; using pg8::cvt_pk_bf16;

__device__ const float ROPE_INV[64] = {
1.000000000e+00f, 8.659643531e-01f, 7.498942614e-01f, 6.493816376e-01f, 5.623413324e-01f, 4.869675338e-01f, 4.216965139e-01f, 3.651741147e-01f, 3.162277639e-01f, 2.738419771e-01f, 2.371373773e-01f, 2.053525001e-01f, 1.778279394e-01f, 1.539926529e-01f, 1.333521307e-01f, 1.154782027e-01f, 1.000000015e-01f, 8.659642935e-02f, 7.498941571e-02f, 6.493816525e-02f, 5.623413250e-02f, 4.869675264e-02f, 4.216965288e-02f, 3.651741147e-02f, 3.162277490e-02f, 2.738419734e-02f, 2.371373773e-02f, 2.053525113e-02f, 1.778279431e-02f, 1.539926510e-02f, 1.333521493e-02f, 1.154782064e-02f, 9.999999776e-03f, 8.659643121e-03f, 7.498941850e-03f, 6.493816152e-03f, 5.623413250e-03f, 4.869675264e-03f, 4.216964822e-03f, 3.651741194e-03f, 3.162277630e-03f, 2.738419687e-03f, 2.371373586e-03f, 2.053524833e-03f, 1.778279431e-03f, 1.539926510e-03f, 1.333521446e-03f, 1.154781901e-03f, 1.000000047e-03f, 8.659643354e-04f, 7.498942432e-04f, 6.493816618e-04f, 5.623413017e-04f, 4.869675322e-04f, 4.216965172e-04f, 3.651741426e-04f, 3.162277571e-04f, 2.738419571e-04f, 2.371373703e-04f, 2.053525095e-04f, 1.778279402e-04f, 1.539926452e-04f, 1.333521504e-04f, 1.154782003e-04f };
__device__ const float LOG_GAMMA[8] = { -3.174869716e-02f, -1.574835740e-02f, -7.843177766e-03f, -3.913899418e-03f, -1.955034910e-03f, -9.770396864e-04f, -4.884005175e-04f, -2.441704273e-04f };

__device__ __forceinline__ float wave_sum(float v) {
#pragma unroll
    for (int o = 1; o < 64; o <<= 1) v += __shfl_xor(v, o);
    return v;
}
#define LDS_WAIT() asm volatile("s_waitcnt lgkmcnt(0)" ::: "memory")

struct Args { const float* in[15]; float* out; unsigned char* ws; int ph_lo, ph_hi; };
__device__ __forceinline__ int bxl() { int b = blockIdx.x; asm volatile("" : "+s"(b)); return b; }
typedef const __attribute__((address_space(4))) Args* ArgP;
__device__ __forceinline__ ArgP argp() { ArgP p = (ArgP)__builtin_amdgcn_kernarg_segment_ptr(); asm volatile("" : "+s"(p)); return p; }
enum { I_XP = 0, I_XS, I_SRET, I_SCONV, I_META, I_NMG, I_WIN, I_CONVW, I_WRET, I_WCONV, I_WO, I_NFG, I_WGU, I_WDN, I_FNG };

__device__ __forceinline__ void p0_transpose_item(const float* W, int K, int N, bf16* WT, int dst_row0, LAS float* scr, int k0, int n0, int lane) {
#pragma unroll 8
    for (int i = 0; i < 32; ++i) { const int kk = 2 * i + (lane >> 5); scr[kk * 33 + (lane & 31)] = W[(size_t)(k0 + kk) * N + n0 + (lane & 31)]; }
    LDS_WAIT(); asm volatile("" ::: "memory");
    const int c = lane & 7;
#pragma unroll
    for (int j = 0; j < 4; ++j) { const int n = (lane >> 3) + 8 * j; const LAS float* s = scr + (8 * c) * 33 + n;
        u32x4 o; o.x = cvt_pk_bf16(s[0 * 33], s[1 * 33]); o.y = cvt_pk_bf16(s[2 * 33], s[3 * 33]); o.z = cvt_pk_bf16(s[4 * 33], s[5 * 33]); o.w = cvt_pk_bf16(s[6 * 33], s[7 * 33]);
        *(u32x4*)(WT + (size_t)(dst_row0 + n) * K + k0 + 8 * c) = o; }
    LDS_WAIT(); asm volatile("" ::: "memory");
}
__device__ __forceinline__ int map_in(int n0) {
    const int seg = n0 >> 10, j = n0 & 1023;
    if (seg < 2) { const int X = j >> 7, d = j & 127; return seg * 1024 + (X >> 1) * 256 + (d >> 6) * 128 + (X & 1) * 64 + (d & 63); }
    if (seg == 5) return 5120 + (j >> 7) * 256 + (j & 127);
    if (seg == 6) return 5120 + (j >> 7) * 256 + 128 + (j & 127);
    return n0;
}
__device__ __forceinline__ int map_gu(int n0) {
    if (n0 < DFF) return (n0 >> 7) * 256 + (n0 & 127);
    const int j = n0 - DFF; return (j >> 7) * 256 + 128 + (j & 127);
}
__device__ __forceinline__ void sincos_d(double r, double& s, double& c) {
    const double r2 = r * r;
    double ts = 1.0, tc = 1.0, ss = 1.0, cc = 1.0;
#pragma unroll
    for (int n = 1; n <= 15; ++n) { tc *= -r2 / (double)((2 * n - 1) * (2 * n)); ts *= -r2 / (double)((2 * n) * (2 * n + 1)); cc += tc; ss += ts; }
    s = ss * r; c = cc;
}

__device__ __forceinline__ void rms_row(const f32x4 (&v)[4], const float* g, int lane, float& rs, f32x4 (&y)[4]) {
    float s = 0.f;
#pragma unroll
    for (int j = 0; j < 4; ++j) s += (v[j].x * v[j].x + v[j].y * v[j].y) + (v[j].z * v[j].z + v[j].w * v[j].w);
    rs = __builtin_amdgcn_rsqf(wave_sum(s) * (1.f / DM) + EPS);
#pragma unroll
    for (int j = 0; j < 4; ++j) { const f32x4 gv = *((const f32x4*)g + lane + 64 * j); y[j] = v[j] * rs * gv; }
}
__device__ __forceinline__ void load_bf16_row(const bf16* row, int lane, f32x4 (&v)[4]) {
    const u32x2* p = (const u32x2*)row + lane;
#pragma unroll
    for (int j = 0; j < 4; ++j) { const u32x2 w = p[64 * j]; v[j] = (f32x4){bflo(w.x), bfhi(w.x), bflo(w.y), bfhi(w.y)}; }
}
__device__ __forceinline__ void store_bf16_row(bf16* orow, int lane, const f32x4 (&y)[4]) {
    u32x2* o8 = (u32x2*)orow + lane;
#pragma unroll
    for (int j = 0; j < 4; ++j) { u32x2 w; w.x = cvt_pk_bf16(y[j].x, y[j].y); w.y = cvt_pk_bf16(y[j].z, y[j].w); o8[64 * j] = w; }
}

constexpr int IT_IN = (DM / 64) * (NIN / 32), IT_SQ = (DM / 64) * (DM / 32), IT_GU = (DM / 64) * (2 * DFF / 32), IT_DN = (DFF / 64) * (DM / 32);
constexpr int IT_LAYER = IT_IN + 3 * IT_SQ + IT_GU + IT_DN;
__device__ __forceinline__ void convert_weights(ArgP a, LAS float* scr, int lane, int first, int count, int gw, int NGW) {
    unsigned char* ws = a->ws;
    for (int it0 = gw; it0 < count; it0 += NGW) {
        const int it = first + it0;
        const int l = it / IT_LAYER; int r = it - l * IT_LAYER;
        unsigned char* wl = ws + WS_W + (size_t)l * W_LAYER;
        if (r < IT_IN) { const int nblk = NIN / 32, kb = r / nblk, nb = r % nblk; p0_transpose_item(a->in[I_WIN] + (size_t)l * DM * NIN, DM, NIN, (bf16*)(wl + W_IN), map_in(nb * 32), scr, kb * 64, nb * 32, lane); continue; } r -= IT_IN;
        if (r < 3 * IT_SQ) { const int which = r / IT_SQ; r -= which * IT_SQ; const int nblk = DM / 32, kb = r / nblk, nb = r % nblk;
            const float* W = (which == 0 ? a->in[I_WRET] : which == 1 ? a->in[I_WCONV] : a->in[I_WO]) + (size_t)l * DM * DM;
            bf16* WT = (bf16*)(wl + (which == 0 ? W_RET : which == 1 ? W_CONV : W_O));
            p0_transpose_item(W, DM, DM, WT, nb * 32, scr, kb * 64, nb * 32, lane); continue; } r -= 3 * IT_SQ;
        if (r < IT_GU) { const int nblk = 2 * DFF / 32, kb = r / nblk, nb = r % nblk; p0_transpose_item(a->in[I_WGU] + (size_t)l * DM * 2 * DFF, DM, 2 * DFF, (bf16*)(wl + W_GU), map_gu(nb * 32), scr, kb * 64, nb * 32, lane); continue; } r -= IT_GU;
        { const int nblk = DM / 32, kb = r / nblk, nb = r % nblk; p0_transpose_item(a->in[I_WDN] + (size_t)l * DFF * DM, DFF, DM, (bf16*)(wl + W_DN), nb * 32, scr, kb * 64, nb * 32, lane); }
    }
}

__device__ __forceinline__ void p0_prologue(ArgP a, LAS unsigned char* lds, int G) {
    int tid_ = threadIdx.x; asm volatile("" : "+v"(tid_));
    const int tid = tid_, lane = tid & 63, wave = tid >> 6;
    LAS float* scr = (LAS float*)(lds + wave * 16384);
    const int gw = blockIdx.x * NWAVES + wave, NGW = G * NWAVES;
    unsigned char* ws = a->ws;
    convert_weights(a, scr, lane, 0, IT_IN, gw, NGW);
    convert_weights(a, scr, lane, IT_IN, 2 * IT_SQ, gw, NGW);
    {
        f32x2* tab = (f32x2*)(ws + WS_TAB);
        for (int idx = blockIdx.x * NTHREADS + tid; idx < NPOS * 64; idx += G * NTHREADS) {
            const int p = idx >> 6, i = idx & 63;
            const float pos = (float)(p < SEQ + NMETA ? p : 16384 + (p - (SEQ + NMETA)));
            const float ang = pos * ROPE_INV[i];
            const double ad = (double)ang;
            const double k = __builtin_rint(ad * 0.15915494309189535);
            double r = __builtin_fma(-k, 6.283185307179586, ad); r = __builtin_fma(-k, 2.4492935982947064e-16, r);
            double s, c; sincos_d(r, s, c);
            tab[idx] = (f32x2){(float)c, (float)s};
        }
    }
    bf16* H = (bf16*)(ws + WS_H); bf16* XN = (bf16*)(ws + WS_XN);
    for (int m = gw; m < MP; m += NGW) {
        f32x4 v[4];
        if (m < M_REAL) {
            const float* src = m < R_META ? a->in[I_XP] + (size_t)m * DM : m < R_SAMP ? a->in[I_META] + (size_t)((m - R_META) & 15) * DM : a->in[I_XS] + (size_t)(m - R_SAMP) * DM;
#pragma unroll
            for (int j = 0; j < 4; ++j) v[j] = *((const f32x4*)src + lane + 64 * j);
        } else {
#pragma unroll
            for (int j = 0; j < 4; ++j) { float z = 0.f; asm volatile("" : "+v"(z)); v[j] = (f32x4){z, z, z, z}; }
        }
        if (m >= R_META) store_bf16_row(H + (size_t)m * DM, lane, v);
        float rs; f32x4 y[4]; rms_row(v, a->in[I_NMG], lane, rs, y);
        store_bf16_row(XN + (size_t)m * DM, lane, y);
    }
}

template <int NSLICE> __device__ __forceinline__ void rms_phase(ArgP a, const float* g, bool final_out, int G) {
    int tid_ = threadIdx.x; asm volatile("" : "+v"(tid_));
    const int tid = tid_, lane = tid & 63, wave = tid >> 6;
    const int gw = blockIdx.x * NWAVES + wave, NGW = G * NWAVES;
    bf16* H = (bf16*)(a->ws + WS_H); bf16* XN = (bf16*)(a->ws + WS_XN);
    for (int m = gw; m < R_META; m += 2 * NGW) {
        const int m2 = m + NGW; const bool has2 = m2 < R_META;
        f32x4 v[4], u[4];
        load_bf16_row(H + (size_t)m * DM, lane, v); load_bf16_row(H + (size_t)(has2 ? m2 : m) * DM, lane, u);
        float rs; f32x4 y[4];
        rms_row(v, g, lane, rs, y);
        if (!final_out) store_bf16_row(XN + (size_t)m * DM, lane, y);
        else { float* o = a->out + O_YP + (size_t)m * DM;
#pragma unroll
            for (int j = 0; j < 4; ++j) *((f32x4*)o + lane + 64 * j) = y[j]; }
        if (has2) {
            rms_row(u, g, lane, rs, y);
            if (!final_out) store_bf16_row(XN + (size_t)m2 * DM, lane, y);
            else { float* o = a->out + O_YP + (size_t)m2 * DM;
#pragma unroll
                for (int j = 0; j < 4; ++j) *((f32x4*)o + lane + 64 * j) = y[j]; }
        }
    }
    for (int t = (NGW - 1 - gw); t < M_REAL - R_META; t += NGW) {
        const int m = R_META + t;
        if (final_out && m < R_SAMP) continue;
        f32x4 v[4]; load_bf16_row(H + (size_t)m * DM, lane, v);
        const bf16* PART = (const bf16*)(a->ws + WS_P + 6 * ROWBUF) + (size_t)t * DM;
#pragma unroll
        for (int sl = 0; sl < NSLICE; ++sl) {
            f32x4 pv[4]; load_bf16_row(PART + (size_t)sl * (MP - R_META) * DM, lane, pv);
#pragma unroll
            for (int j = 0; j < 4; ++j) v[j] = v[j] + pv[j];
        }
        if (!final_out) store_bf16_row(H + (size_t)m * DM, lane, v);
        float rs; f32x4 y[4]; rms_row(v, g, lane, rs, y);
        if (!final_out) store_bf16_row(XN + (size_t)m * DM, lane, y);
        else { float* o = a->out + O_YS + (size_t)(m - R_SAMP) * DM;
#pragma unroll
            for (int j = 0; j < 4; ++j) *((f32x4*)o + lane + 64 * j) = y[j]; }
    }
}

constexpr int PT = 136, PTB = PT * 2;
constexpr int RG0 = 0, RG1 = 128 * PTB, RG2 = 2 * RG1, RG3 = 3 * RG1, RG4 = 4 * RG1;
static_assert(RG4 + 128 * 4 * 8 <= LDS_BYTES, "retention LDS map");
__device__ __forceinline__ bf16x8 ldfrag(LAS unsigned char* base, int row, int kel) { return *(const LAS bf16x8*)(base + row * PTB + kel * 2); }
#define MFMA16(a, b, c) __builtin_amdgcn_mfma_f32_16x16x32_bf16((a), (b), (c), 0, 0, 0)

#ifndef CHAIN_GPRE
#define CHAIN_GPRE 1
#endif
#define CHAIN_BAR() do { asm volatile("s_waitcnt lgkmcnt(0)" ::: "memory"); __builtin_amdgcn_s_barrier(); asm volatile("" ::: "memory"); } while (0)
typedef short s16x4 __attribute__((ext_vector_type(4)));
__device__ __forceinline__ bf16x8 ldfrag_tr(LAS unsigned char* base, int k0, int n0, int l15, int quad) {
    LAS unsigned char* p = base + (k0 + 8 * quad + (l15 >> 2)) * PTB + (n0 + 4 * (l15 & 3)) * 2;
    const s16x4 lo = __builtin_amdgcn_ds_read_tr16_b64_v4i16((LAS s16x4*)p);
    const s16x4 hi = __builtin_amdgcn_ds_read_tr16_b64_v4i16((LAS s16x4*)(p + 4 * PTB));
    return (bf16x8){lo[0], lo[1], lo[2], lo[3], hi[0], hi[1], hi[2], hi[3]};
}

template <bool STORE> __device__ __forceinline__ void ret_chain(LAS unsigned char* lds, int b, int h, bf16* Qb, const bf16* Kb, const bf16* Vb, const bf16* Gb, const f32x2* tab, float* s_out) {
    int tid_ = threadIdx.x; asm volatile("" : "+v"(tid_));
    const int tid = tid_, lane = tid & 63, w = tid >> 6, wr = w >> 2, wc = w & 3, l15 = lane & 15, quad = lane >> 4;
    const float lg = LOG_GAMMA[h];
    float zf_ = 0.f; asm volatile("" : "+v"(zf_)); const f32x4 zero4 = {zf_, zf_, zf_, zf_}; const u32x4 zero4u = __builtin_bit_cast(u32x4, zero4);
    f32x4 acc_s[4][2];
#pragma unroll
    for (int x = 0; x < 4; ++x)
#pragma unroll
        for (int y = 0; y < 2; ++y) acc_s[x][y] = zero4;
    for (int idx = tid; idx < 128 * PTB / 16; idx += NTHREADS) *(LAS u32x4*)(lds + RG3 + idx * 16) = zero4u;
    u32x4 rq[4], rk[4], rv[4];
#define CHAIN_LOAD(ci_) do { const int Leff_ = (ci_) == 0 ? NMETA : 128; const int rb_ = (ci_) == 0 ? (R_META + b * NMETA) : (b * SEQ + ((ci_) - 1) * 128); \
        _Pragma("unroll") for (int it = 0; it < 4; ++it) { const int item = tid + NTHREADS * it, j = item >> 4, c = item & 15; \
            const size_t goff = (size_t)(rb_ + (j < Leff_ ? j : 0)) * DM + h * HD + 8 * c; \
            rq[it] = *(const u32x4*)(Qb + goff); rk[it] = *(const u32x4*)(Kb + goff); rv[it] = *(const u32x4*)(Vb + goff); } } while (0)
    CHAIN_LOAD(0);
    for (int ci = 0; ci < 17; ++ci) {
        const int Leff = ci == 0 ? NMETA : 128;
        const int row_base = ci == 0 ? (R_META + b * NMETA) : (b * SEQ + (ci - 1) * 128);
#pragma unroll
        for (int it = 0; it < 4; ++it) {
            const int item = tid + NTHREADS * it, j = item >> 4, c = item & 15;
            const bool valid = j < Leff;
            const float kd = valid ? __expf(lg * (float)(Leff - 1 - j)) : 0.f;
            const u32x4 q = valid ? rq[it] : zero4u, k = valid ? rk[it] : zero4u, v = rv[it];
            u32x4 vs;
#pragma unroll
            for (int p = 0; p < 4; ++p) vs[p] = cvt_pk_bf16(bflo(v[p]) * kd, bfhi(v[p]) * kd);
            const int boff = j * PTB + (8 * c) * 2;
            *(LAS u32x4*)(lds + RG0 + boff) = q; *(LAS u32x4*)(lds + RG1 + boff) = k; *(LAS u32x4*)(lds + RG2 + boff) = vs;
        }
        CHAIN_BAR();
        if (ci + 1 < 17) CHAIN_LOAD(ci + 1);
        f32x4 acc_p[4][2], acc_o[4][2];
#pragma unroll
        for (int x = 0; x < 4; ++x)
#pragma unroll
            for (int y = 0; y < 2; ++y) { acc_p[x][y] = zero4; acc_o[x][y] = zero4; }
#pragma unroll
        for (int ks = 0; ks < 4; ++ks) {
            const int kel = ks * 32 + quad * 8;
            bf16x8 qf[4], kf[2], sf[2];
#pragma unroll
            for (int ti = 0; ti < 4; ++ti) qf[ti] = ldfrag(lds + RG0, 64 * wr + 16 * ti + l15, kel);
#pragma unroll
            for (int t = 0; t < 2; ++t) { kf[t] = ldfrag(lds + RG1, 32 * wc + 16 * t + l15, kel); sf[t] = ldfrag(lds + RG3, 32 * wc + 16 * t + l15, kel); }
#pragma unroll
            for (int ti = 0; ti < 4; ++ti)
#pragma unroll
                for (int t = 0; t < 2; ++t) { if (32 * wc + 16 * t <= 64 * wr + 16 * ti + 15) acc_p[ti][t] = MFMA16(kf[t], qf[ti], acc_p[ti][t]);
                    acc_o[ti][t] = MFMA16(sf[t], qf[ti], acc_o[ti][t]); }
        }
        CHAIN_BAR();
        {
            const float pscale = __expf(-lg * (float)Leff);
#pragma unroll
            for (int ti = 0; ti < 4; ++ti)
#pragma unroll
                for (int t = 0; t < 2; ++t) {
                    const int i = 64 * wr + 16 * ti + l15, jb = 32 * wc + 16 * t + 4 * quad;
                    float p[4];
#pragma unroll
                    for (int r = 0; r < 4; ++r) p[r] = (jb + r <= i) ? acc_p[ti][t][r] * pscale : 0.f;
                    u32x2 wv; wv.x = cvt_pk_bf16(p[0], p[1]); wv.y = cvt_pk_bf16(p[2], p[3]);
                    *(LAS u32x2*)(lds + RG0 + i * PTB + jb * 2) = wv;
                }
        }
        CHAIN_BAR();
#if CHAIN_GPRE
        u32x2 gpre[4][2];
#pragma unroll
        for (int ti = 0; ti < 4; ++ti) { const int i = 64 * wr + 16 * ti + l15; const size_t roff = (size_t)(row_base + (i < Leff ? i : 0)) * DM + h * HD;
#pragma unroll
            for (int t = 0; t < 2; ++t) gpre[ti][t] = *(const u32x2*)(Gb + roff + 32 * wc + 16 * t + 4 * quad); }
#endif
        {
            const float sdec = __expf(lg * (float)Leff);
#pragma unroll
            for (int x = 0; x < 4; ++x)
#pragma unroll
                for (int y = 0; y < 2; ++y) acc_s[x][y] = acc_s[x][y] * sdec;
        }
#pragma unroll
        for (int ks = 0; ks < 4; ++ks) {
            const int kel = ks * 32 + quad * 8;
            bf16x8 pf[4], ktf[4], vf[2];
#pragma unroll
            for (int ti = 0; ti < 4; ++ti) { pf[ti] = ldfrag(lds + RG0, 64 * wr + 16 * ti + l15, kel); ktf[ti] = ldfrag_tr(lds + RG1, ks * 32, 64 * wr + 16 * ti, l15, quad); }
#pragma unroll
            for (int t = 0; t < 2; ++t) vf[t] = ldfrag_tr(lds + RG2, ks * 32, 32 * wc + 16 * t, l15, quad);
#pragma unroll
            for (int ti = 0; ti < 4; ++ti)
#pragma unroll
                for (int t = 0; t < 2; ++t) { if (32 * ks <= 64 * wr + 16 * ti + 15) acc_o[ti][t] = MFMA16(vf[t], pf[ti], acc_o[ti][t]);
                    acc_s[ti][t] = MFMA16(ktf[ti], vf[t], acc_s[ti][t]); }
        }
        LAS f32x2* stats = (LAS f32x2*)(lds + RG4);
#pragma unroll
        for (int ti = 0; ti < 4; ++ti) {
            float s = 0.f, q = 0.f;
#pragma unroll
            for (int t = 0; t < 2; ++t)
#pragma unroll
                for (int r = 0; r < 4; ++r) { const float x = acc_o[ti][t][r]; s += x; q += x * x; }
            s += __shfl_xor(s, 16); s += __shfl_xor(s, 32); q += __shfl_xor(q, 16); q += __shfl_xor(q, 32);
            if (quad == 0) stats[(64 * wr + 16 * ti + l15) * 4 + wc] = (f32x2){s, q};
        }
#pragma unroll
        for (int td = 0; td < 4; ++td)
#pragma unroll
            for (int t = 0; t < 2; ++t) {
                const int e = 32 * wc + 16 * t + l15, d = 64 * wr + 16 * td + 4 * quad;
                u32x2 wv; wv.x = cvt_pk_bf16(acc_s[td][t][0], acc_s[td][t][1]); wv.y = cvt_pk_bf16(acc_s[td][t][2], acc_s[td][t][3]);
                *(LAS u32x2*)(lds + RG3 + e * PTB + d * 2) = wv;
            }
        CHAIN_BAR();
#pragma unroll
        for (int ti = 0; ti < 4; ++ti) {
            const int i = 64 * wr + 16 * ti + l15;
            if (STORE && i < Leff) {
                const f32x2 s0 = stats[i * 4 + 0], s1 = stats[i * 4 + 1], s2 = stats[i * 4 + 2], s3 = stats[i * 4 + 3];
                const float mean = ((s0.x + s1.x) + (s2.x + s3.x)) * (1.f / HD);
                const float var = fmaxf(((s0.y + s1.y) + (s2.y + s3.y)) * (1.f / HD) - mean * mean, 0.f);
                const float cinv = __expf(-lg * (float)(i + 1));
                const float rstd = __builtin_amdgcn_rsqf(var + EPS * cinv * cinv);
                const size_t roff = (size_t)(row_base + i) * DM + h * HD;
#pragma unroll
                for (int t = 0; t < 2; ++t) {
                    const int e0 = 32 * wc + 16 * t + 4 * quad;
#if CHAIN_GPRE
                    const u32x2 gw = gpre[ti][t];
#else
                    const u32x2 gw = *(const u32x2*)(Gb + roff + e0);
#endif
                    u32x2 wv;
                    wv.x = cvt_pk_bf16(bflo(gw.x) * (acc_o[ti][t][0] - mean) * rstd, bfhi(gw.x) * (acc_o[ti][t][1] - mean) * rstd);
                    wv.y = cvt_pk_bf16(bflo(gw.y) * (acc_o[ti][t][2] - mean) * rstd, bfhi(gw.y) * (acc_o[ti][t][3] - mean) * rstd);
                    *(u32x2*)(Qb + roff + e0) = wv;
                }
            }
        }
    }
#undef CHAIN_LOAD
    if (STORE)
#pragma unroll
    for (int td = 0; td < 4; ++td)
#pragma unroll
        for (int t = 0; t < 2; ++t)
#pragma unroll
            for (int r = 0; r < 4; ++r) s_out[(size_t)(64 * wr + 16 * td + 4 * quad + r) * HD + 32 * wc + 16 * t + l15] = acc_s[td][t][r];
    __syncthreads();
}

template <bool STORE> __device__ __forceinline__ void ret_sample_item(LAS unsigned char* lds, int db, int h, bf16* Qb, const bf16* Kb, const bf16* Vb, const bf16* Gb, const f32x2* tab, const float* s_in, float* s_out) {
    int tid_ = threadIdx.x; asm volatile("" : "+v"(tid_));
    const int tid = tid_, lane = tid & 63, w = tid >> 6;
    LAS float* qT = (LAS float*)lds;
    LAS float* kT = qT + 1024;
    LAS float* vS = kT + 1024;
    LAS float* sc = vS + 1024;
    LAS float* red = sc + 64;
    const float lg = LOG_GAMMA[h];
    const int row0 = R_SAMP + db * DSEQ;
    const int e4 = (tid & 31) * 4, dg = tid >> 5;
    f32x4 st[8];
    {
        const float* sp = s_in + (size_t)(dg * 8) * HD + e4;
#pragma unroll
        for (int dl = 0; dl < 8; ++dl) st[dl] = *(const f32x4*)(sp + (size_t)dl * HD);
    }
    {
        const int i = tid >> 6, dd = tid & 63;
        const size_t goff = (size_t)(row0 + i) * DM + h * HD + dd;
        const float q1 = __builtin_bit_cast(float, (unsigned)Qb[goff] << 16), q2 = __builtin_bit_cast(float, (unsigned)Qb[goff + 64] << 16);
        const float k1 = __builtin_bit_cast(float, (unsigned)Kb[goff] << 16), k2 = __builtin_bit_cast(float, (unsigned)Kb[goff + 64] << 16);
        const float kdsc = __expf(lg * (float)(DSEQ - 1 - i));
        qT[dd * 8 + i] = q1; qT[(dd + 64) * 8 + i] = q2;
        kT[dd * 8 + i] = k1 * kdsc; kT[(dd + 64) * 8 + i] = k2 * kdsc;
#pragma unroll
        for (int t = 0; t < 2; ++t) { const int idx = tid + NTHREADS * t, vi = idx >> 7, ve = idx & 127; vS[idx] = __builtin_bit_cast(float, (unsigned)Vb[(size_t)(row0 + vi) * DM + h * HD + ve] << 16); }
    }
    __syncthreads();
    {
        const int i = w, j = lane & 7, g = lane >> 3; float s = 0.f;
#pragma unroll
        for (int dl = 0; dl < 16; ++dl) { const int d = g * 16 + dl; s += qT[d * 8 + i] * kT[d * 8 + j]; }
        s += __shfl_xor(s, 8); s += __shfl_xor(s, 16); s += __shfl_xor(s, 32);
        if (g == 0) sc[i * 8 + j] = (j <= i) ? s * __expf(lg * (float)(i - (DSEQ - 1))) : 0.f;
    }
    {
        f32x4 vv[8], cr[8];
#pragma unroll
        for (int j = 0; j < 8; ++j) { vv[j] = *(const LAS f32x4*)(vS + j * 128 + e4); cr[j] = (f32x4){0.f, 0.f, 0.f, 0.f}; }
        const float g8 = __expf(lg * (float)DSEQ);
        float* op = s_out + (size_t)(dg * 8) * HD + e4;
#pragma unroll
        for (int dl = 0; dl < 8; ++dl) {
            const int d = dg * 8 + dl; const f32x4 s = st[dl];
            const f32x4 qa = *(const LAS f32x4*)(qT + d * 8), qb = *(const LAS f32x4*)(qT + d * 8 + 4);
            const f32x4 ka = *(const LAS f32x4*)(kT + d * 8), kb = *(const LAS f32x4*)(kT + d * 8 + 4);
            cr[0] += s * qa.x; cr[1] += s * qa.y; cr[2] += s * qa.z; cr[3] += s * qa.w; cr[4] += s * qb.x; cr[5] += s * qb.y; cr[6] += s * qb.z; cr[7] += s * qb.w;
            f32x4 sn = s * g8;
            sn += vv[0] * ka.x; sn += vv[1] * ka.y; sn += vv[2] * ka.z; sn += vv[3] * ka.w; sn += vv[4] * kb.x; sn += vv[5] * kb.y; sn += vv[6] * kb.z; sn += vv[7] * kb.w;
            if (STORE) *(f32x4*)(op + (size_t)dl * HD) = sn;
        }
#pragma unroll
        for (int i = 0; i < 8; ++i) *(LAS f32x4*)(red + (dg * 8 + i) * 128 + e4) = cr[i];
    }
    __syncthreads();
    {
        const int i = w; float o[2];
#pragma unroll
        for (int t = 0; t < 2; ++t) {
            const int e = lane + 64 * t;
            float cr = 0.f;
#pragma unroll
            for (int g = 0; g < 16; ++g) cr += red[(g * 8 + i) * 128 + e];
            float x = cr * __expf(lg * (float)(i + 1));
#pragma unroll
            for (int j = 0; j < 8; ++j) x += sc[i * 8 + j] * vS[j * 128 + e];
            o[t] = x;
        }
        const float mean = wave_sum(o[0] + o[1]) * (1.f / HD);
        const float d0 = o[0] - mean, d1 = o[1] - mean;
        const float var = wave_sum(d0 * d0 + d1 * d1) * (1.f / HD);
        const float rstd = __builtin_amdgcn_rsqf(var + EPS);
        const size_t roff = (size_t)(row0 + i) * DM + h * HD;
        const float g0 = __builtin_bit_cast(float, (unsigned)Gb[roff + lane] << 16), g1 = __builtin_bit_cast(float, (unsigned)Gb[roff + lane + 64] << 16);
        if (STORE) { Qb[roff + lane] = (bf16)(cvt_pk_bf16(g0 * d0 * rstd, 0.f) & 0xffffu);
        Qb[roff + lane + 64] = (bf16)(cvt_pk_bf16(g1 * d1 * rstd, 0.f) & 0xffffu); }
        else if (g0 * d0 * rstd + g1 * d1 * rstd == 12345.678f) Qb[roff + lane] = 0;
    }
    __syncthreads();
}

__device__ __forceinline__ void ld8(const bf16* p, float (&x)[8]) { const u32x4 w = *(const u32x4*)p; x[0] = bflo(w.x); x[1] = bfhi(w.x); x[2] = bflo(w.y); x[3] = bfhi(w.y); x[4] = bflo(w.z); x[5] = bfhi(w.z); x[6] = bflo(w.w); x[7] = bfhi(w.w); }
__device__ __forceinline__ void ld8f(const float* p, float (&x)[8]) { const f32x4 a = *(const f32x4*)p, b = *(const f32x4*)(p + 4); x[0] = a.x; x[1] = a.y; x[2] = a.z; x[3] = a.w; x[4] = b.x; x[5] = b.y; x[6] = b.z; x[7] = b.w; }
__device__ __forceinline__ void conv_block(ArgP a, int layer, int r0, int lane, const bf16* U, bf16* BG) {
    int kind = 0; size_t r1 = 0, r2 = 0; const float* c1 = nullptr; const float* c2 = nullptr; float* st_out = nullptr;
    if (r0 < R_META) { const int b = r0 >> 11, s = r0 & (SEQ - 1);
        if (s >= 4) { r1 = r0 - 1; r2 = r0 - 2; } else { r1 = R_META + b * NMETA + 15; r2 = R_META + b * NMETA + 14; }
        if (s == SEQ - 4) st_out = a->out + O_SCP + (size_t)(layer * NB + b) * 2 * DM;
    } else if (r0 < R_SAMP) { const int j = (r0 - R_META) & 15;
        if (j >= 4) { r1 = r0 - 1; r2 = r0 - 2; } else kind = 1;
    } else { const int db = (r0 - R_SAMP) >> 3, i = (r0 - R_SAMP) & 7; const float* cp = a->in[I_SCONV] + (size_t)(layer * DBATCH + db) * 2 * DM;
        if (i >= 4) { r1 = r0 - 1; r2 = r0 - 2; } else { kind = 2; c1 = cp + DM; c2 = cp; }
        if (i == DSEQ - 4) st_out = a->out + O_SCS + (size_t)(layer * DBATCH + db) * 2 * DM;
    }
    const float* cw = a->in[I_CONVW] + (size_t)layer * 3 * DM;
#pragma unroll 1
    for (int q = 0; q < 2; ++q) {
        const int col = lane * 8 + 512 * q;
        u32x4 uw[4], bw[4], p1w = {0u, 0u, 0u, 0u}, p2w = {0u, 0u, 0u, 0u};
#pragma unroll
        for (int k = 0; k < 4; ++k) { uw[k] = *(const u32x4*)(U + (size_t)(r0 + k) * DM + col); bw[k] = *(const u32x4*)(BG + (size_t)(r0 + k) * DM + col); }
        float p1[8], p2[8], w0[8], w1[8], w2[8];
        if (kind == 0) { p1w = *(const u32x4*)(U + r1 * DM + col); p2w = *(const u32x4*)(U + r2 * DM + col); }
        else if (kind == 2) { ld8f(c1 + col, p1); ld8f(c2 + col, p2); }
        ld8f(cw + col, w0); ld8f(cw + DM + col, w1); ld8f(cw + 2 * DM + col, w2);
        if (kind != 2) { const u32x4 a1 = p1w, a2 = p2w;
            p1[0] = bflo(a1.x); p1[1] = bfhi(a1.x); p1[2] = bflo(a1.y); p1[3] = bfhi(a1.y); p1[4] = bflo(a1.z); p1[5] = bfhi(a1.z); p1[6] = bflo(a1.w); p1[7] = bfhi(a1.w);
            p2[0] = bflo(a2.x); p2[1] = bfhi(a2.x); p2[2] = bflo(a2.y); p2[3] = bfhi(a2.y); p2[4] = bflo(a2.z); p2[5] = bfhi(a2.z); p2[6] = bflo(a2.w); p2[7] = bfhi(a2.w); }
#pragma unroll
        for (int k = 0; k < 4; ++k) {
            float u0[8], bg[8], y[8];
            { const u32x4 w = uw[k]; u0[0] = bflo(w.x); u0[1] = bfhi(w.x); u0[2] = bflo(w.y); u0[3] = bfhi(w.y); u0[4] = bflo(w.z); u0[5] = bfhi(w.z); u0[6] = bflo(w.w); u0[7] = bfhi(w.w); }
            { const u32x4 w = bw[k]; bg[0] = bflo(w.x); bg[1] = bfhi(w.x); bg[2] = bflo(w.y); bg[3] = bfhi(w.y); bg[4] = bflo(w.z); bg[5] = bfhi(w.z); bg[6] = bflo(w.w); bg[7] = bfhi(w.w); }
#pragma unroll
            for (int x = 0; x < 8; ++x) y[x] = bg[x] * (w0[x] * p2[x] + w1[x] * p1[x] + w2[x] * u0[x]);
            u32x4 wv; wv.x = cvt_pk_bf16(y[0], y[1]); wv.y = cvt_pk_bf16(y[2], y[3]); wv.z = cvt_pk_bf16(y[4], y[5]); wv.w = cvt_pk_bf16(y[6], y[7]);
            *(u32x4*)(BG + (size_t)(r0 + k) * DM + col) = wv;
            if (st_out && k >= 2) { float* so = st_out + (size_t)(k - 2) * DM + col; *(f32x4*)so = (f32x4){u0[0], u0[1], u0[2], u0[3]}; *(f32x4*)(so + 4) = (f32x4){u0[4], u0[5], u0[6], u0[7]}; }
#pragma unroll
            for (int x = 0; x < 8; ++x) { p2[x] = p1[x]; p1[x] = u0[x]; }
        }
    }
}

__device__ __forceinline__ void mixer_phase(ArgP a, LAS unsigned char* lds, int layer, int G) {
    unsigned char* ws = a->ws;
    bf16* P = (bf16*)(ws + WS_P); const size_t BS = ROWBUF / 2;
    bf16* Qb = P; const bf16* Kb = P + BS; const bf16* Vb = P + 2 * BS; const bf16* Gb = P + 3 * BS; bf16* BGb = P + 4 * BS; const bf16* Ub = P + 5 * BS;
    const f32x2* tab = (const f32x2*)(ws + WS_TAB);
    const int wgi = blockIdx.x;
    for (int ci = wgi; ci < NB * NH; ci += G) {
        const int b = ci >> 3, h = ci & 7;
#ifdef PROBE_CHAIN
        ret_chain<false>(lds, b, h, Qb, Kb, Vb, Gb, tab, a->out + O_SRP + ((size_t)(layer * NB + b) * NH + h) * HD * HD);
#endif
        ret_chain<true>(lds, b, h, Qb, Kb, Vb, Gb, tab, a->out + O_SRP + ((size_t)(layer * NB + b) * NH + h) * HD * HD);
    }
    const int first_other = (G > NB * NH) ? NB * NH : 0, n_other = G - first_other;
    if (wgi >= first_other) {
        const int oi = wgi - first_other;
        int tid_ = threadIdx.x; asm volatile("" : "+v"(tid_));
        const int lane = tid_ & 63, wave = tid_ >> 6;
        unsigned* cnt = (unsigned*)(ws + WS_CTL) + 3584 + 64 * layer;
        for (int blk = oi * NWAVES + wave; blk < M_REAL / 4; blk += n_other * NWAVES) conv_block(a, layer, blk * 4, lane, Ub, BGb);
        asm volatile("s_waitcnt vmcnt(0)" ::: "memory"); __syncthreads();
        if (tid_ == 0) { __builtin_amdgcn_fence(__ATOMIC_RELEASE, "agent"); asm volatile("s_waitcnt vmcnt(0)" ::: "memory"); (void)__hip_atomic_fetch_add(cnt, 1u, __ATOMIC_RELAXED, __HIP_MEMORY_SCOPE_AGENT); }
        for (int it = oi; it < DBATCH * NH; it += n_other) {
            const int db = it >> 3, h = it & 7; const size_t so = ((size_t)(layer * DBATCH + db) * NH + h) * HD * HD;
#ifdef PROBE_OTHERS
            ret_sample_item<false>(lds, db, h, Qb, Kb, Vb, Gb, tab, a->in[I_SRET] + so, a->out + O_SRS + so);
#endif
            ret_sample_item<true>(lds, db, h, Qb, Kb, Vb, Gb, tab, a->in[I_SRET] + so, a->out + O_SRS + so);
        }
        if (tid_ == 0) { unsigned sp = 0; while (__hip_atomic_load(cnt, __ATOMIC_RELAXED, __HIP_MEMORY_SCOPE_AGENT) < (unsigned)n_other) { __builtin_amdgcn_s_sleep(2); if (++sp > (1u << 22)) break; }
            __builtin_amdgcn_fence(__ATOMIC_ACQUIRE, "agent"); asm volatile("s_waitcnt vmcnt(0)" ::: "memory"); }
        __syncthreads();
        {
            pg8::Gemm g{BGb  , (const bf16*)(ws + WS_W + (size_t)layer * W_LAYER + W_CONV), MP, DM, DM}; pg8::EpiGate<false> E{P + 5 * BS  , P + 7 * BS  };
            { pg8::OneOf S; S.init(MP, DM, DM, oi < CO_LO ? oi : oi + (CO_HI - CO_LO));
                pg8::gemm_phase<pg8::EpiGate<false>, pg8::OneOf, true, true>(lds, g, S, E); }
        }
        if (layer > 0) { __syncthreads();
            convert_weights(a, (LAS float*)(lds + wave * 16384), lane, layer * IT_LAYER + IT_IN, IT_SQ, oi * NWAVES + wave, n_other * NWAVES);
            convert_weights(a, (LAS float*)(lds + wave * 16384), lane, layer * IT_LAYER + IT_IN + 2 * IT_SQ, IT_LAYER - IT_IN - 2 * IT_SQ, oi * NWAVES + wave, n_other * NWAVES); }
        if (layer + 1 < DEPTH) { __syncthreads(); convert_weights(a, (LAS float*)(lds + wave * 16384), lane, (layer + 1) * IT_LAYER, IT_IN, oi * NWAVES + wave, n_other * NWAVES); }
    }
}

#define XB_TMO      128
#define XB_XCNT(j)  (256  + 64 * (j))
#define XB_XSUB(j)  (1280 + 64 * (j))
#define XB_XGEN(j)  (2304 + 64 * (j))
#define XB_TOP      3328
#define XB_TOPGEN   3392
#define XCD_BAR_WORDS 3456
#define XB_SPIN_CAP (1u << 18)

__device__ __forceinline__ unsigned xb_ld(unsigned* p)              { return __hip_atomic_load(p, __ATOMIC_RELAXED, __HIP_MEMORY_SCOPE_AGENT); }
__device__ __forceinline__ unsigned xb_add(unsigned* p, unsigned v) { return __hip_atomic_fetch_add(p, v, __ATOMIC_RELAXED, __HIP_MEMORY_SCOPE_AGENT); }
__device__ __forceinline__ unsigned xb_xcc_id() { return (unsigned)__builtin_amdgcn_s_getreg((3 << 11) | 20) & 0xFu; }
#define XB_SPIN(cond, bar) do { unsigned _sp = 0; while (cond) { __builtin_amdgcn_s_sleep(1); \
    if ((++_sp & 255u) == 0u) { if (xb_ld(&(bar)[XB_TMO])) break; if (_sp > XB_SPIN_CAP) { atomicAdd(&(bar)[XB_TMO], 1u); break; } } } } while (0)

struct XcdBarrier {
    unsigned* bar; unsigned x;
    volatile LAS unsigned* st;
};

__device__ __forceinline__ XcdBarrier xcd_barrier_post(unsigned* bar, volatile LAS unsigned* st) {
    XcdBarrier b; b.bar = bar; b.x = xb_xcc_id(); b.st = st;
    if (threadIdx.x == 0) (void)xb_add(&bar[XB_XCNT(b.x)], 1u);
    return b;
}
__device__ __forceinline__ void xcd_barrier_complete(unsigned* bar, unsigned x, unsigned& nloc, unsigned& nx) {
    const unsigned G = gridDim.x * gridDim.y * gridDim.z;
    unsigned sum, cnt, mine, sp = 0u;
    for (;;) {
        sum = 0u; cnt = 0u; mine = 0u;
#pragma unroll
        for (unsigned j = 0; j < 16; ++j) { const unsigned c = xb_ld(&bar[XB_XCNT(j)]); sum += c; cnt += (c > 0u) ? 1u : 0u; mine = (j == x) ? c : mine; }
        if (sum == G) break;
        __builtin_amdgcn_s_sleep(1);
        if ((++sp & 255u) == 0u) { if (xb_ld(&bar[XB_TMO])) break; if (sp > XB_SPIN_CAP) { atomicAdd(&bar[XB_TMO], 1u); break; } }
    }
    nloc = mine > 0u ? mine : 1u; nx = cnt > 0u ? cnt : 1u;
}

__device__ __forceinline__ void xcd_barrier(const XcdBarrier& b) {
    asm volatile("s_waitcnt vmcnt(0)" ::: "memory");
    __syncthreads();
    if (threadIdx.x == 0) {
        unsigned* bar = b.bar;
        __builtin_amdgcn_s_waitcnt(0);
        unsigned nloc = b.st[0], nx = b.st[1];
        if (nloc == 0u) { xcd_barrier_complete(bar, b.x, nloc, nx); b.st[0] = nloc; b.st[1] = nx; }
        const unsigned old = xb_add(&bar[XB_XSUB(b.x)], 1u);
        const unsigned gen = old / nloc;
        if (old + 1u == (gen + 1u) * nloc) {
            __builtin_amdgcn_fence(__ATOMIC_RELEASE, "agent");
            asm volatile("s_waitcnt vmcnt(0)" ::: "memory");
            const unsigned og = xb_add(&bar[XB_TOP], 1u);
            const unsigned tg = og / nx;
            if (og + 1u == (tg + 1u) * nx) xb_add(&bar[XB_TOPGEN], 1u);
            else XB_SPIN(xb_ld(&bar[XB_TOPGEN]) == tg, bar);
            __builtin_amdgcn_fence(__ATOMIC_ACQUIRE, "agent");
            xb_add(&bar[XB_XGEN(b.x)], 1u);
            asm volatile("s_waitcnt vmcnt(0)" ::: "memory");
        } else {
            XB_SPIN(xb_ld(&bar[XB_XGEN(b.x)]) == gen, bar);
            __builtin_amdgcn_fence(__ATOMIC_ACQUIRE, "agent");
            asm volatile("s_waitcnt vmcnt(0)" ::: "memory");
        }
    }
    __syncthreads();
}

constexpr int N_PHASES = 1 + 8 * DEPTH;
__global__ void __launch_bounds__(NTHREADS, 2) fwd_megakernel(Args a_) {
    ArgP a = argp();
    extern __shared__ __attribute__((aligned(16))) unsigned char lds_raw[];
    LAS unsigned char* lds = (LAS unsigned char*)lds_raw;
    cg::grid_group grid = cg::this_grid();
    const int G = gridDim.x;
    unsigned char* ws = a->ws;
    bf16* XN = (bf16*)(ws + WS_XN); bf16* H = (bf16*)(ws + WS_H);
    bf16* P = (bf16*)(ws + WS_P); const size_t BS = ROWBUF / 2;
    bf16* MG = P + 5 * BS  ; bf16* ACT = P + BS;
#define IN(k) true
#ifdef ONLY
#define PHON(x) ((x) == ONLY)
#else
#define PHON(x) true
#endif
#ifdef PROBE_SYNC
#define SEAM(k) do { if (IN(k) && IN((k) + 1)) { xcd_barrier(xbar); xcd_barrier(xbar); } } while (0)
#else
#define SEAM(k) do { if (IN(k) && IN((k) + 1)) { XcdBarrier b_ = xbar; asm volatile("" : "+s"(b_.bar), "+s"(b_.x)); xcd_barrier(b_); } } while (0)
#endif
    unsigned* ctl = (unsigned*)(ws + WS_CTL);
    if (blockIdx.x == 0) for (int i = threadIdx.x; i < 4096; i += NTHREADS) __hip_atomic_store(ctl + i, 0u, __ATOMIC_RELAXED, __HIP_MEMORY_SCOPE_AGENT);
    volatile LAS unsigned* xst = (volatile LAS unsigned*)(lds + LDS_BYTES - 64);
    if (threadIdx.x < 2) xst[threadIdx.x] = 0u;
    __syncthreads();
#ifdef PROBE_P0
    if (IN(0)) { p0_prologue(argp(), lds, G); __syncthreads(); }
#endif
    if (IN(0)) { p0_prologue(argp(), lds, G); __syncthreads(); }
    grid.sync();
    XcdBarrier xbar = xcd_barrier_post(ctl, xst);
#pragma unroll 1
    for (int l = 0; l < DEPTH; ++l) {
        const int pb = 1 + 8 * l;
        const unsigned char* wl = ws + WS_W + (size_t)l * W_LAYER;
        if (PHON(0) && IN(pb + 0)) {
            pg8::Gemm g{XN, (const bf16*)(wl + W_IN), MP, NIN, DM}; pg8::StaticOrder S; S.init(MP, NIN, G, bxl(), DM);
            pg8::EpiProj E{P, BS, (const float*)(ws + WS_TAB)};
            pg8::gemm_phase<pg8::EpiProj, pg8::StaticOrder, true, true>(lds, g, S, E);
#ifdef PROBE_G16
            pg8::gemm_phase<pg8::EpiProj, pg8::StaticOrder, true, true>(lds, g, S, E);
#endif
        }
        SEAM(pb + 0);
        #ifndef NO_MIXER
        if (PHON(1) && IN(pb + 1)) mixer_phase(argp(), lds, l, G);
#endif
        SEAM(pb + 1);
        if (PHON(2) && IN(pb + 2)) {
            { const int bx = bxl(); pg8::OneOf S0; S0.init(MP, DM, DM, (bx >= CO_LO && bx < CO_HI) ? bx : -1);
                pg8::Gemm g{P + 4 * BS  , (const bf16*)(wl + W_CONV), MP, DM, DM}; pg8::EpiGate<false> E{MG, P + 7 * BS};
                pg8::gemm_phase<pg8::EpiGate<false>, pg8::OneOf, true, true>(lds, g, S0, E); }
            pg8::StaticOrder S; S.init(MP, DM, G, bxl(), DM);
            { pg8::Gemm g{P  , (const bf16*)(wl + W_RET), MP, DM, DM}; pg8::EpiGate<true> E{MG, P + 6 * BS};
              pg8::gemm_phase<pg8::EpiGate<true>, pg8::StaticOrder, true, true>(lds, g, S, E); }
            {
                const int nbusy = (MP / 256) * (DM / 256) - G, first = CO_HI, bx = bxl();
                if (bx >= first) { int tid_ = threadIdx.x; asm volatile("" : "+v"(tid_)); const int lane = tid_ & 63, wave = tid_ >> 6;
                    LAS float* scr = (LAS float*)(lds + wave * 16384); const int fw = (bx - first) * NWAVES + wave, nfw = (G - first) * NWAVES;
                    if (l == 0) convert_weights(argp(), scr, lane, IT_IN + 2 * IT_SQ, IT_LAYER - IT_IN - 2 * IT_SQ, fw, nfw);
                    if (l + 1 < DEPTH) convert_weights(argp(), scr, lane, (l + 1) * IT_LAYER + IT_IN + IT_SQ, IT_SQ, fw, nfw); }
            }
        }
        SEAM(pb + 2);
        if (PHON(3) && IN(pb + 3)) {
            pg8::Gemm g{MG, (const bf16*)(wl + W_O), MP, DM, DM}; pg8::SplitOrder<4, DM / 256> S; S.init(R_META, MP, DM, DM, G, bxl());
            pg8::EpiResid E{l == 0 ? argp()->in[I_XP] : (const float*)nullptr, H, (bf16*)(ws + WS_P + 6 * ROWBUF), DM / 64, R_META, MP - R_META};
            pg8::gemm_phase<pg8::EpiResid, pg8::SplitOrder<4, DM / 256>, true, true>(lds, g, S, E);
        }
        SEAM(pb + 3);
        if (PHON(4) && IN(pb + 4)) rms_phase<4>(argp(), argp()->in[I_NFG] + (size_t)l * DM, false, G);
        SEAM(pb + 4);
        if (PHON(5) && IN(pb + 5)) {
            pg8::Gemm g{XN, (const bf16*)(wl + W_GU), MP, 2 * DFF, DM}; pg8::StaticOrder S; S.init(MP, 2 * DFF, G, bxl(), DM);
            pg8::EpiGateUp E{ACT, DFF};
            pg8::gemm_phase<pg8::EpiGateUp, pg8::StaticOrder, true, true>(lds, g, S, E);
#ifdef PROBE_G16
            pg8::gemm_phase<pg8::EpiGateUp, pg8::StaticOrder, true, true>(lds, g, S, E);
#endif
        }
        SEAM(pb + 5);
        if (PHON(6) && IN(pb + 6)) {
            pg8::Gemm g{ACT, (const bf16*)(wl + W_DN), MP, DM, DFF}; pg8::SplitOrder<11, DM / 256> S; S.init(R_META, MP, DM, DFF, G, bxl());
            pg8::EpiResid E{nullptr, H, (bf16*)(ws + WS_P + 6 * ROWBUF), DFF / 64, R_META, MP - R_META};
            pg8::gemm_phase<pg8::EpiResid, pg8::SplitOrder<11, DM / 256>, true, true>(lds, g, S, E);
        }
        SEAM(pb + 6);
        if (PHON(7) && IN(pb + 7)) { if (l + 1 < DEPTH) rms_phase<11>(argp(), argp()->in[I_NMG] + (size_t)(l + 1) * DM, false, G); else rms_phase<11>(argp(), argp()->in[I_FNG], true, G); }
        if (l + 1 < DEPTH) SEAM(pb + 7);
    }
#undef IN
#undef SEAM
}

extern "C" void kernel_launch(void* const* d_in, const int* in_sizes, int n_in, void* d_out, int out_size, void* d_ws, size_t ws_size, hipStream_t stream) {
    static int grid = 0;
    if (grid == 0) {
        if (n_in != 15 || (size_t)out_size != O_END || ws_size < WS_END) { fprintf(stderr, "kernel_launch: unexpected shapes: n_in %d out %d ws %zu (need %zu)\n", n_in, out_size, ws_size, (size_t)WS_END); grid = -1; return; }
        int dev = 0, cus = 0, per_cu = 0;
        hipGetDevice(&dev);
        hipDeviceGetAttribute(&cus, hipDeviceAttributeMultiprocessorCount, dev);
        if (hipFuncSetAttribute((const void*)fwd_megakernel, hipFuncAttributeMaxDynamicSharedMemorySize, LDS_BYTES) != hipSuccess) { fprintf(stderr, "kernel_launch: hipFuncSetAttribute failed\n"); grid = -1; return; }
        if (hipOccupancyMaxActiveBlocksPerMultiprocessor(&per_cu, (const void*)fwd_megakernel, NTHREADS, LDS_BYTES) != hipSuccess || per_cu < 1) { fprintf(stderr, "kernel_launch: occupancy query failed (%d)\n", per_cu); (void)hipGetLastError(); per_cu = 1; }
        if (per_cu > 1) per_cu = 1;
        grid = cus * per_cu;
        if (grid != 256) { fprintf(stderr, "kernel_launch: this build deals its mixer-phase GEMM units for exactly 256 workgroups (got %d); nothing launched\n", grid); grid = -1; return; }
    }
    if (grid < 0) return;
    Args a{};
    for (int i = 0; i < 15; ++i) a.in[i] = (const float*)d_in[i];
    a.out = (float*)d_out; a.ws = (unsigned char*)d_ws; a.ph_lo = 0; a.ph_hi = N_PHASES;
    void* args[] = {&a};
    hipError_t e = hipLaunchCooperativeKernel((const void*)fwd_megakernel, dim3(grid), dim3(NTHREADS), args, LDS_BYTES, stream);
    if (e != hipSuccess) fprintf(stderr, "cooperative launch failed: %s (grid %d)\n", hipGetErrorString(e), grid);
}
```
